# Optimizing an MI355X kernel written in HIP

```python
import math
import jax, jax.numpy as jnp
from jax import lax
import numpy as np

D_MODEL = 2048
BATCH = 2
SEQ = 16384
DEPTH = 1

HEAD_DIM = 128
A_Q_HEADS = 8
A_KV_HEADS = 2
A_REP = A_Q_HEADS // A_KV_HEADS
WINDOW = 128
BLOCK = 128
B_HEADS = 4
D_FF = 5632
ROPE_THETA = 10000.0
EPS = 1e-6
NEG_INF = -1e30

A_Q = A_Q_HEADS * HEAD_DIM
A_KV = A_KV_HEADS * HEAD_DIM
A_WIDTH = A_Q
B_QK = B_HEADS * 2 * HEAD_DIM
B_V = B_HEADS * 2 * HEAD_DIM
B_WIDTH = B_V
GATE_W = 2 * D_MODEL
W_IN_COLS = A_Q + 2 * A_KV + 2 * B_QK + B_V + GATE_W
SPLITS = tuple(np.cumsum([A_Q, A_KV, A_KV, B_QK, B_QK, B_V, D_MODEL])[:].tolist())

kernel_name = "hybrid_gated_window_gqa_diff_attn_macaron"


def rmsnorm(x, g):
    xf = x.astype(jnp.float32)
    y = xf * lax.rsqrt(jnp.mean(xf * xf, axis=-1, keepdims=True) + EPS)
    return (y * g.astype(jnp.float32)).astype(x.dtype)


def swiglu(h, w_gate, w_up, w_down):
    return (jax.nn.silu(h @ w_gate) * (h @ w_up)) @ w_down


def rope_tables(seq, dim):
    pos = jnp.arange(seq, dtype=jnp.float32)
    inv = ROPE_THETA ** (-jnp.arange(0, dim, 2, dtype=jnp.float32) / dim)
    ang = pos[:, None] * inv[None, :]
    return jnp.cos(ang), jnp.sin(ang)


def apply_rope(x, cos, sin):
    shape = (1, x.shape[1]) + (1,) * (x.ndim - 3) + (x.shape[-1] // 2,)
    c, s = cos.reshape(shape), sin.reshape(shape)
    xf = x.astype(jnp.float32)
    x1, x2 = jnp.split(xf, 2, axis=-1)
    return jnp.concatenate([x1 * c - x2 * s, x2 * c + x1 * s], axis=-1).astype(x.dtype)


def windowed_gqa_sink(q, k, v, sink):
    b, s = q.shape[0], q.shape[1]
    nb = s // BLOCK
    qb = q.reshape(b, nb, BLOCK, A_KV_HEADS, A_REP, HEAD_DIM)

    def band(t):
        tp = jnp.pad(t, ((0, 0), (BLOCK, BLOCK), (0, 0), (0, 0)))
        tb = tp.reshape(b, nb + 2, BLOCK, A_KV_HEADS, HEAD_DIM)
        return jnp.concatenate([tb[:, :-2], tb[:, 1:-1], tb[:, 2:]], axis=2)

    kband, vband = band(k), band(v)
    scores = jnp.einsum('bnqgrd,bnkgd->bngrqk', qb, kband,
                        preferred_element_type=jnp.float32) * (HEAD_DIM ** -0.5)
    blk = jnp.arange(nb)[:, None, None] * BLOCK
    qpos = blk + jnp.arange(BLOCK)[None, :, None]
    kpos = blk + jnp.arange(3 * BLOCK)[None, None, :] - BLOCK
    valid = (jnp.abs(kpos - qpos) <= WINDOW) & (kpos >= 0) & (kpos < s)
    scores = jnp.where(valid[None, :, None, None], scores, NEG_INF)
    sk = sink.astype(jnp.float32).reshape(1, 1, A_KV_HEADS, A_REP, 1, 1)
    m = jnp.maximum(jnp.max(scores, axis=-1, keepdims=True), sk)
    e = jnp.exp(scores - m)
    p = e / (jnp.sum(e, axis=-1, keepdims=True) + jnp.exp(sk - m))
    out = jnp.einsum('bngrqk,bnkgd->bnqgrd', p.astype(v.dtype), vband)
    return out.reshape(b, s, A_WIDTH)


def differential_attention(q, k, v, lam, subln_g, lam_init):
    b, s = q.shape[0], q.shape[1]
    nb = s // BLOCK
    qblocks = jnp.moveaxis(q.reshape(b, nb, BLOCK, B_HEADS, 2, HEAD_DIM), 1, 0)

    def one_block(qblk):
        sc = jnp.einsum('bqhcd,bkhcd->bhcqk', qblk, k,
                        preferred_element_type=jnp.float32) * (HEAD_DIM ** -0.5)
        p = jax.nn.softmax(sc, axis=-1)
        attn = p[:, :, 0] - lam * p[:, :, 1]
        return jnp.einsum('bhqk,bkhe->bqhe', attn.astype(v.dtype), v)

    out = lax.map(one_block, qblocks)
    out = jnp.moveaxis(out, 0, 1).reshape(b, s, B_HEADS, 2 * HEAD_DIM)
    out = rmsnorm(out, subln_g) * (1.0 - lam_init)
    return out.reshape(b, s, B_WIDTH)


def setup_inputs(seed: int = 0) -> dict:
    key = jax.random.key(seed)
    ks = jax.random.split(key, 24)
    L = DEPTH

    def nrm(k, shape, fan_in):
        return jax.random.normal(k, shape, jnp.float32) * (fan_in ** -0.5)

    def gain(k, dim):
        return 1.0 + 0.05 * jax.random.normal(k, (L, dim), jnp.float32)

    return {
        "x": jax.random.normal(ks[0], (BATCH, SEQ, D_MODEL), jnp.float32),
        "ffn1_pre_g": gain(ks[1], D_MODEL),
        "ffn1_w_gate": nrm(ks[2], (L, D_MODEL, D_FF), D_MODEL),
        "ffn1_w_up": nrm(ks[3], (L, D_MODEL, D_FF), D_MODEL),
        "ffn1_w_down": nrm(ks[4], (L, D_FF, D_MODEL), D_FF),
        "ffn1_post_g": gain(ks[5], D_MODEL),
        "mix_pre_g": gain(ks[6], D_MODEL),
        "w_in": nrm(ks[7], (L, D_MODEL, W_IN_COLS), D_MODEL),
        "gate_bias": 0.01 * jax.random.normal(ks[8], (L, GATE_W), jnp.float32),
        "sink_logit": 0.5 * jax.random.normal(ks[9], (L, A_Q_HEADS), jnp.float32),
        "lambda_q1": 0.1 * jax.random.normal(ks[10], (L, HEAD_DIM), jnp.float32),
        "lambda_k1": 0.1 * jax.random.normal(ks[11], (L, HEAD_DIM), jnp.float32),
        "lambda_q2": 0.1 * jax.random.normal(ks[12], (L, HEAD_DIM), jnp.float32),
        "lambda_k2": 0.1 * jax.random.normal(ks[13], (L, HEAD_DIM), jnp.float32),
        "subln_g": gain(ks[14], 2 * HEAD_DIM),
        "w_proj_a": nrm(ks[15], (L, A_WIDTH, D_MODEL), A_WIDTH),
        "w_proj_b": nrm(ks[16], (L, B_WIDTH, D_MODEL), B_WIDTH),
        "w_out": nrm(ks[17], (L, D_MODEL, D_MODEL), D_MODEL),
        "mix_post_g": gain(ks[18], D_MODEL),
        "ffn2_pre_g": gain(ks[19], D_MODEL),
        "ffn2_w_gate": nrm(ks[20], (L, D_MODEL, D_FF), D_MODEL),
        "ffn2_w_up": nrm(ks[21], (L, D_MODEL, D_FF), D_MODEL),
        "ffn2_w_down": nrm(ks[22], (L, D_FF, D_MODEL), D_FF),
        "ffn2_post_g": gain(ks[23], D_MODEL),
    }


def reference(x, ffn1_pre_g, ffn1_w_gate, ffn1_w_up, ffn1_w_down, ffn1_post_g,
              mix_pre_g, w_in, gate_bias, sink_logit, lambda_q1, lambda_k1, lambda_q2,
              lambda_k2, subln_g, w_proj_a, w_proj_b, w_out, mix_post_g,
              ffn2_pre_g, ffn2_w_gate, ffn2_w_up, ffn2_w_down, ffn2_post_g):
    b, s = x.shape[0], x.shape[1]
    cos, sin = rope_tables(s, HEAD_DIM)
    for l in range(DEPTH):
        lam_init = 0.8 - 0.6 * math.exp(-0.3 * l)
        f = swiglu(rmsnorm(x, ffn1_pre_g[l]), ffn1_w_gate[l], ffn1_w_up[l], ffn1_w_down[l])
        x = x + 0.5 * rmsnorm(f, ffn1_post_g[l])

        h = rmsnorm(x, mix_pre_g[l])
        proj = h @ w_in[l]
        qa, ka, va, qb, kb, vb, ga, gb = jnp.split(proj, SPLITS, axis=-1)
        ga = jax.nn.sigmoid(ga + gate_bias[l, :D_MODEL])
        gb = jax.nn.sigmoid(gb + gate_bias[l, D_MODEL:])

        qa = apply_rope(qa.reshape(b, s, A_Q_HEADS, HEAD_DIM), cos, sin)
        ka = apply_rope(ka.reshape(b, s, A_KV_HEADS, HEAD_DIM), cos, sin)
        va = va.reshape(b, s, A_KV_HEADS, HEAD_DIM)
        out_a = windowed_gqa_sink(qa, ka, va, sink_logit[l])

        qb = apply_rope(qb.reshape(b, s, B_HEADS, 2, HEAD_DIM), cos, sin)
        kb = apply_rope(kb.reshape(b, s, B_HEADS, 2, HEAD_DIM), cos, sin)
        vb = vb.reshape(b, s, B_HEADS, 2 * HEAD_DIM)
        lam = (jnp.exp(jnp.sum(lambda_q1[l].astype(jnp.float32) * lambda_k1[l].astype(jnp.float32)))
               - jnp.exp(jnp.sum(lambda_q2[l].astype(jnp.float32) * lambda_k2[l].astype(jnp.float32)))
               + lam_init)
        out_b = differential_attention(qb, kb, vb, lam, subln_g[l], lam_init)

        merged = ga * (out_a @ w_proj_a[l]) + gb * (out_b @ w_proj_b[l])
        x = x + rmsnorm(merged @ w_out[l], mix_post_g[l])

        f = swiglu(rmsnorm(x, ffn2_pre_g[l]), ffn2_w_gate[l], ffn2_w_up[l], ffn2_w_down[l])
        x = x + 0.5 * rmsnorm(f, ffn2_post_g[l])
    return x
```

```cpp
#include <hip/hip_runtime.h>
#include <hip/hip_bf16.h>
#include <hip/hip_cooperative_groups.h>
#include <cstdio>
#include <cstdint>
#include <cmath>
namespace cg = cooperative_groups;
namespace pg8 {
#define PG8_LAS __attribute__((address_space(3)))
typedef unsigned short bf16_t;
typedef short bf16x8 __attribute__((ext_vector_type(8)));
typedef float f32x4 __attribute__((ext_vector_type(4)));
typedef unsigned u32x4 __attribute__((ext_vector_type(4)));
constexpr int BM = 256, BK = 64, HALF = 128, HTB = HALF * BK * 2  , STAGE_BYTES = 8 * HTB, NXCD = 8, WGM = 8;

__host__ __device__ __forceinline__ int lds_byte(int r, int c) { const int st = (r >> 4) * 2 + (c >> 5), rr = r & 15, cc = c & 31, ob = rr * 64 + cc * 2; return st * 1024 + (ob ^ (((ob >> 9) & 1) << 5)); }
__host__ __device__ __forceinline__ void stage_rc(int b, int& R, int& C) { const int st = b / 1024, sb = b % 1024, swz = sb ^ (((sb >> 9) & 1) << 5); R = (st >> 1) * 16 + swz / 64; C = (st & 1) * 32 + (swz % 64) / 2; }
__host__ __device__ __forceinline__ int perm32(int rho) { const int n = rho >> 4, i = rho & 15; return 8 * (i >> 2) + 4 * n + (i & 3); }

struct Unit { int pm, pn; };
struct Gemm { const bf16_t* A; const bf16_t* Bt; int M, N, K; };

struct StaticOrder {
    int nM, nN, nwg, G, c;
    __host__ __device__ void init(int M, int N, int G_, int c_) { nM = M / BM; nN = N / BM; nwg = nM * nN; G = G_; c = c_; }
    __host__ __device__ bool next(int i, Unit& u) const {
        const long L = (long)i * G + c; if (L >= nwg) return false;
        int wgid = (int)L; { const int q = nwg / NXCD, r = nwg % NXCD, xcd = wgid % NXCD, off = wgid / NXCD; wgid = (xcd < r ? xcd * (q + 1) : r * (q + 1) + (xcd - r) * q) + off; }
        const int nig = WGM * nN, gid = wgid / nig, fm = gid * WGM, gsz = (nM - fm) < WGM ? (nM - fm) : WGM;
        u.pm = fm + ((wgid % nig) % gsz); u.pn = (wgid % nig) / gsz; return true;
    }
    __device__ __forceinline__ void a_ready(const Unit&) const {}
    __device__ __forceinline__ void done(const Unit&) const {}
};
typedef float f32x2_t __attribute__((ext_vector_type(2))); typedef __bf16 bf16x2_t __attribute__((ext_vector_type(2)));
__device__ __forceinline__ unsigned cvt_pk_bf16(float lo, float hi) { f32x2_t v = {lo, hi}; bf16x2_t b = __builtin_convertvector(v, bf16x2_t); return __builtin_bit_cast(unsigned, b); }
typedef float f32x2 __attribute__((ext_vector_type(2)));
__device__ __forceinline__ float bf_lo(unsigned w) { return __uint_as_float(w << 16); }
__device__ __forceinline__ float bf_hi(unsigned w) { return __uint_as_float(w & 0xffff0000u); }
__device__ __forceinline__ u32x4 pack8(const f32x4 a, const f32x4 b) { u32x4 w; w.x = cvt_pk_bf16(a[0], a[1]); w.y = cvt_pk_bf16(a[2], a[3]); w.z = cvt_pk_bf16(b[0], b[1]); w.w = cvt_pk_bf16(b[2], b[3]); return w; }
__device__ __forceinline__ float sigmoid_f(float v) { return __builtin_amdgcn_rcpf(1.0f + __builtin_amdgcn_exp2f(-1.4426950408889634f * v)); }

struct EpiStore {
    static constexpr bool PERM = true, AFTER_DRAIN = false;
    bf16_t* O; int ldc;
    __device__ __forceinline__ void operator()(const f32x4 (&acc)[2][2][4][2], const Unit& u, int wr, int wc, int fr, int fq) const {
        const int row0 = u.pm * BM + wr * 64 + fr, col0 = u.pn * BM + wc * 32 + 8 * fq;
#pragma unroll
        for (int ai = 0; ai < 2; ++ai)
#pragma unroll
            for (int m = 0; m < 4; ++m) { bf16_t* rowp = O + (size_t)(row0 + ai * HALF + m * 16) * ldc + col0;
#pragma unroll
                for (int bj = 0; bj < 2; ++bj) *(u32x4*)(rowp + bj * HALF) = pack8(acc[ai][bj][m][0], acc[ai][bj][m][1]); }
    }
};
struct EpiSwiGLU {
    static constexpr bool PERM = true, AFTER_DRAIN = false;
    bf16_t* O; int ldc;
    __device__ __forceinline__ void operator()(const f32x4 (&acc)[2][2][4][2], const Unit& u, int wr, int wc, int fr, int fq) const {
        const int row0 = u.pm * BM + wr * 64 + fr, col0 = u.pn * HALF + wc * 32 + 8 * fq;
#pragma unroll
        for (int ai = 0; ai < 2; ++ai)
#pragma unroll
            for (int m = 0; m < 4; ++m) { f32x4 h[2];
#pragma unroll
                for (int n = 0; n < 2; ++n) { const f32x4 g = acc[ai][0][m][n], v = acc[ai][1][m][n];
#pragma unroll
                    for (int e = 0; e < 4; ++e) h[n][e] = g[e] * sigmoid_f(g[e]) * v[e]; }
                *(u32x4*)(O + (size_t)(row0 + ai * HALF + m * 16) * ldc + col0) = pack8(h[0], h[1]); }
    }
};
struct EpiProj {
    static constexpr bool PERM = true, AFTER_DRAIN = false;
    bf16_t *QA, *KA, *VA, *QB, *KB, *VB, *GA, *GB; const float* cosT; const float* sinT; const float* gbias;
    __device__ __forceinline__ void operator()(const f32x4 (&acc)[2][2][4][2], const Unit& u, int wr, int wc, int fr, int fq) const {
        const int pn = u.pn, row0 = u.pm * BM + wr * 64 + fr;
        const bool rope = (pn <= 4) || (pn >= 6 && pn <= 13);
        if (rope) {
            const int i0 = (wc & 1) * 32 + 8 * fq, hl = wc >> 1;
            bf16_t* hb; int nh, hd;
            if (pn <= 3) { hb = QA; nh = 8; hd = 2 * pn + hl; } else if (pn == 4) { hb = KA; nh = 2; hd = hl; } else if (pn <= 9) { hb = QB; nh = 8; hd = 2 * (pn - 6) + hl; } else { hb = KB; nh = 8; hd = 2 * (pn - 10) + hl; }
#pragma unroll
            for (int ai = 0; ai < 2; ++ai)
#pragma unroll
                for (int m = 0; m < 4; ++m) { const int row = row0 + ai * HALF + m * 16, pos = row & 16383, b = row >> 14;
                    const f32x4* cp = (const f32x4*)(cosT + (size_t)pos * 64 + i0); const f32x4* sp = (const f32x4*)(sinT + (size_t)pos * 64 + i0);
                    f32x4 y1[2], y2[2];
#pragma unroll
                    for (int n = 0; n < 2; ++n) { const f32x4 c = cp[n], s = sp[n], x1 = acc[ai][0][m][n], x2 = acc[ai][1][m][n]; y1[n] = x1 * c - x2 * s; y2[n] = x2 * c + x1 * s; }
                    bf16_t* rowp = hb + ((size_t)(b * nh + hd) * 16384 + pos) * 128 + i0;
                    *(u32x4*)(rowp) = pack8(y1[0], y1[1]); *(u32x4*)(rowp + 64) = pack8(y2[0], y2[1]); }
        } else if (pn < 18) {
            const int dcol = wc * 32 + 8 * fq;
#pragma unroll
            for (int ai = 0; ai < 2; ++ai)
#pragma unroll
                for (int m = 0; m < 4; ++m) { const int row = row0 + ai * HALF + m * 16, pos = row & 16383, b = row >> 14;
#pragma unroll
                    for (int bj = 0; bj < 2; ++bj) {
                        bf16_t* dst = (pn == 5) ? VA + ((size_t)(b * 2 + bj) * 16384 + pos) * 128 + dcol
                                                : VB + ((size_t)(b * 4 + (pn - 14)) * 16384 + pos) * 256 + bj * HALF + dcol;
                        *(u32x4*)dst = pack8(acc[ai][bj][m][0], acc[ai][bj][m][1]); } }
        } else {
            const int col0 = pn * BM + wc * 32 + 8 * fq;
            bf16_t* gbuf = (pn < 26) ? GA : GB; const int gcol0 = (pn < 26 ? (pn - 18) : (pn - 26)) * BM + wc * 32 + 8 * fq;
            f32x4 bv[2][2];
#pragma unroll
            for (int bj = 0; bj < 2; ++bj)
#pragma unroll
                for (int n = 0; n < 2; ++n) bv[bj][n] = *(const f32x4*)(gbias + (col0 - 4608) + bj * HALF + 4 * n);
#pragma unroll
            for (int ai = 0; ai < 2; ++ai)
#pragma unroll
                for (int m = 0; m < 4; ++m) { bf16_t* rowp = gbuf + (size_t)(row0 + ai * HALF + m * 16) * 2048 + gcol0;
#pragma unroll
                    for (int bj = 0; bj < 2; ++bj) { f32x4 v[2];
#pragma unroll
                        for (int n = 0; n < 2; ++n) { const f32x4 t = acc[ai][bj][m][n] + bv[bj][n];
#pragma unroll
                            for (int e = 0; e < 4; ++e) v[n][e] = sigmoid_f(t[e]); }
                        *(u32x4*)(rowp + bj * HALF) = pack8(v[0], v[1]); } }
        }
    }
};
template <int PASS> struct EpiGate {
    static constexpr bool PERM = true, AFTER_DRAIN = false;
    bf16_t* T; const bf16_t* gate;
    __device__ __forceinline__ void operator()(const f32x4 (&acc)[2][2][4][2], const Unit& u, int wr, int wc, int fr, int fq) const {
        const int row0 = u.pm * BM + wr * 64 + fr, col0 = u.pn * BM + wc * 32 + 8 * fq;
#pragma unroll
        for (int ai = 0; ai < 2; ++ai) {
            u32x4 gw[4][2], tw[4][2];
#pragma unroll
            for (int m = 0; m < 4; ++m)
#pragma unroll
                for (int bj = 0; bj < 2; ++bj) { const int row = row0 + ai * HALF + m * 16, col = col0 + bj * HALF;
                    gw[m][bj] = *(const u32x4*)(gate + (size_t)row * 2048 + col);
                    if (PASS == 1) tw[m][bj] = *(const u32x4*)(T + (size_t)row * 2048 + col); }
#pragma unroll
            for (int m = 0; m < 4; ++m)
#pragma unroll
                for (int bj = 0; bj < 2; ++bj) { const int row = row0 + ai * HALF + m * 16, col = col0 + bj * HALF;
                    const u32x4 g = gw[m][bj];
                    const f32x4 g0 = {bf_lo(g.x), bf_hi(g.x), bf_lo(g.y), bf_hi(g.y)}, g1 = {bf_lo(g.z), bf_hi(g.z), bf_lo(g.w), bf_hi(g.w)};
                    f32x4 v0 = g0 * acc[ai][bj][m][0], v1 = g1 * acc[ai][bj][m][1];
                    if (PASS == 1) { const u32x4 t = tw[m][bj];
                        v0 += (f32x4){bf_lo(t.x), bf_hi(t.x), bf_lo(t.y), bf_hi(t.y)}; v1 += (f32x4){bf_lo(t.z), bf_hi(t.z), bf_lo(t.w), bf_hi(t.w)}; }
                    *(u32x4*)(T + (size_t)row * 2048 + col) = pack8(v0, v1); }
        }
    }
};

template <class Epi, class Sched, bool ALIGN_EPI = false, bool SP2 = false>
__device__ __forceinline__ void gemm_phase(PG8_LAS unsigned char* lds, const Gemm g, const Sched& S, const Epi& E) {
    const int tid = threadIdx.x, wid = __builtin_amdgcn_readfirstlane(tid >> 6), lane = tid & 63, wr = wid >> 2, wc = wid & 3, fr = lane & 15, fq = lane >> 4;
    const int K = g.K, nt = K / BK;
    unsigned voffA[2], voffB[2];
#pragma unroll
    for (int i = 0; i < 2; ++i) { int R, C; stage_rc(tid * 16 + i * 8192, R, C); const int Rb = Epi::PERM ? ((R & ~31) + perm32(R & 31)) : R;
        voffA[i] = (unsigned)(R * K + C) * 2u; voffB[i] = (unsigned)(Rb * K + C) * 2u; }
    const size_t kstep = (size_t)(BK * 2);
    const size_t hstep = (size_t)HALF * K * 2;
    const size_t tstep = 2 * hstep;
    const unsigned ldsw = (unsigned)wid * 1024u;
    const int aoff = lds_byte(wr * 64 + fr, fq * 8), boff = lds_byte(wc * 32 + fr, fq * 8);
#define PG8_SA(b, h) (((b) * 2 + (h)) * HTB)
#define PG8_SB(b, h) ((4 + (b) * 2 + (h)) * HTB)
#define PG8_STAGE(bufoff, gbase, voff) do { _Pragma("unroll") for (int _i = 0; _i < 2; ++_i) \
        __builtin_amdgcn_global_load_lds((const unsigned*)((const char*)(gbase) + (voff)[_i]), (PG8_LAS unsigned*)(lds + (bufoff) + ldsw + _i * 8192), 16, 0, 0); } while (0)
#define PG8_LDA(dst, b, h) do { _Pragma("unroll") for (int m = 0; m < 4; ++m) _Pragma("unroll") for (int k = 0; k < 2; ++k) dst[m][k] = *(const PG8_LAS bf16x8*)(lds + PG8_SA(b, h) + aoff + m * 2048 + k * 1024); } while (0)
#define PG8_LDB(dst, b, h) do { _Pragma("unroll") for (int n = 0; n < 2; ++n) _Pragma("unroll") for (int k = 0; k < 2; ++k) dst[n][k] = *(const PG8_LAS bf16x8*)(lds + PG8_SB(b, h) + boff + n * 2048 + k * 1024); } while (0)
#define PG8_MMA(ai, bj, At, Bt) do { __builtin_amdgcn_s_setprio(1); _Pragma("unroll") for (int m = 0; m < 4; ++m) _Pragma("unroll") for (int n = 0; n < 2; ++n) _Pragma("unroll") for (int k = 0; k < 2; ++k) \
        acc[ai][bj][m][n] = __builtin_amdgcn_mfma_f32_16x16x32_bf16(Bt[n][k], At[m][k], acc[ai][bj][m][n], 0, 0, 0); __builtin_amdgcn_s_setprio(0); } while (0)
#define PG8_WAIT_V(n) asm volatile("s_waitcnt vmcnt(" #n ")" ::: "memory")
#define PG8_WAIT_L(n) asm volatile("s_waitcnt lgkmcnt(" #n ")" ::: "memory")
#define PG8_BAR __builtin_amdgcn_s_barrier()
#define PG8_SCHED __builtin_amdgcn_sched_barrier(0)
    Unit cur, nxt; int ui = 0;
    if (!S.next(0, cur)) return;
    f32x4 acc[2][2][4][2];
#pragma unroll
    for (int a = 0; a < 2; ++a)
#pragma unroll
        for (int b = 0; b < 2; ++b)
#pragma unroll
            for (int m = 0; m < 4; ++m)
#pragma unroll
                for (int n = 0; n < 2; ++n) acc[a][b][m][n] = (f32x4){0.f, 0.f, 0.f, 0.f};
    bf16x8 At[4][2], B0[2][2], B1[2][2];
    const char* cA = (const char*)g.A + (size_t)cur.pm * tstep; const char* cB = (const char*)g.Bt + (size_t)cur.pn * tstep;
    S.a_ready(cur);
    if constexpr (SP2) {
        PG8_STAGE(PG8_SB(0, 0), cB, voffB); PG8_STAGE(PG8_SB(0, 1), cB + hstep, voffB); PG8_STAGE(PG8_SA(0, 0), cA, voffA); PG8_STAGE(PG8_SA(0, 1), cA + hstep, voffA);
        if (wr == 1) PG8_BAR;
        PG8_WAIT_V(2); PG8_BAR;
        PG8_STAGE(PG8_SB(1, 0), cB + kstep, voffB); PG8_STAGE(PG8_SA(1, 0), cA + kstep, voffA); PG8_STAGE(PG8_SB(1, 1), cB + hstep + kstep, voffB);
        PG8_WAIT_V(6); PG8_BAR;
    } else {
        PG8_STAGE(PG8_SB(0, 0), cB, voffB); PG8_STAGE(PG8_SA(0, 0), cA, voffA); PG8_STAGE(PG8_SB(0, 1), cB + hstep, voffB); PG8_STAGE(PG8_SA(0, 1), cA + hstep, voffA);
        if (wr == 1) PG8_BAR;
        PG8_WAIT_V(4); PG8_BAR;
        PG8_STAGE(PG8_SB(1, 0), cB + kstep, voffB); PG8_STAGE(PG8_SA(1, 0), cA + kstep, voffA); PG8_STAGE(PG8_SB(1, 1), cB + hstep + kstep, voffB);
        PG8_WAIT_V(6); PG8_BAR;
    }
    for (;;) {
        const bool has_next = S.next(ui + 1, nxt);
        const char* nA = has_next ? (const char*)g.A + (size_t)nxt.pm * tstep : cA; const char* nB = has_next ? (const char*)g.Bt + (size_t)nxt.pn * tstep : cB;
        for (int t = 0; t < nt; t += 2) {
            const bool last = (t == nt - 2);
            const char* a1 = cA + (size_t)(t + 1) * kstep;
            const char* a2 = last ? nA : cA + (size_t)(t + 2) * kstep; const char* b2 = last ? nB : cB + (size_t)(t + 2) * kstep;
            const char* a3 = a2 + kstep; const char* b3 = b2 + kstep;
            if (last && has_next) S.a_ready(nxt);
            if constexpr (SP2) {
            PG8_LDB(B0, 0, 0); PG8_LDB(B1, 0, 1); PG8_SCHED; PG8_LDA(At, 0, 0); PG8_STAGE(PG8_SA(1, 1), a1 + hstep, voffA);
            PG8_WAIT_V(8); PG8_WAIT_L(0); PG8_BAR; PG8_MMA(0, 0, At, B0); PG8_MMA(0, 1, At, B1); PG8_BAR; PG8_SCHED;
            PG8_LDA(At, 0, 1); PG8_STAGE(PG8_SB(0, 0), b2, voffB); PG8_STAGE(PG8_SB(0, 1), b2 + hstep, voffB); PG8_STAGE(PG8_SA(0, 0), a2, voffA);
            PG8_WAIT_V(8); PG8_WAIT_L(0); PG8_BAR; PG8_MMA(1, 0, At, B0); PG8_MMA(1, 1, At, B1); PG8_BAR; PG8_SCHED;
            PG8_LDB(B0, 1, 0); PG8_LDB(B1, 1, 1); PG8_SCHED; PG8_LDA(At, 1, 0); PG8_STAGE(PG8_SA(0, 1), a2 + hstep, voffA);
            PG8_WAIT_V(8); PG8_WAIT_L(0); PG8_BAR; PG8_MMA(0, 0, At, B0); PG8_MMA(0, 1, At, B1); PG8_BAR; PG8_SCHED;
            PG8_LDA(At, 1, 1); PG8_STAGE(PG8_SB(1, 0), b3, voffB); PG8_STAGE(PG8_SB(1, 1), b3 + hstep, voffB); PG8_STAGE(PG8_SA(1, 0), a3, voffA);
            PG8_WAIT_V(8); PG8_WAIT_L(0); PG8_BAR; PG8_MMA(1, 0, At, B0); PG8_MMA(1, 1, At, B1); PG8_BAR; PG8_SCHED;
            } else {
            PG8_LDB(B0, 0, 0); PG8_SCHED; PG8_LDA(At, 0, 0); PG8_STAGE(PG8_SA(1, 1), a1 + hstep, voffA);
            PG8_WAIT_L(8); PG8_BAR; PG8_WAIT_L(0); PG8_MMA(0, 0, At, B0); PG8_BAR; PG8_SCHED;
            PG8_LDB(B1, 0, 1); PG8_STAGE(PG8_SB(0, 0), b2, voffB);
            PG8_BAR; PG8_WAIT_L(0); PG8_MMA(0, 1, At, B1); PG8_BAR;
            PG8_LDA(At, 0, 1); PG8_STAGE(PG8_SA(0, 0), a2, voffA);
            PG8_BAR; PG8_WAIT_L(0); PG8_MMA(1, 0, At, B0); PG8_BAR; PG8_SCHED;
            PG8_STAGE(PG8_SB(0, 1), b2 + hstep, voffB);
            PG8_WAIT_V(6); PG8_BAR; PG8_MMA(1, 1, At, B1); PG8_BAR;
            PG8_LDB(B0, 1, 0); PG8_SCHED; PG8_LDA(At, 1, 0); PG8_STAGE(PG8_SA(0, 1), a2 + hstep, voffA);
            PG8_WAIT_L(8); PG8_BAR; PG8_WAIT_L(0); PG8_MMA(0, 0, At, B0); PG8_BAR; PG8_SCHED;
            PG8_LDB(B1, 1, 1); PG8_STAGE(PG8_SB(1, 0), b3, voffB);
            PG8_BAR; PG8_WAIT_L(0); PG8_MMA(0, 1, At, B1); PG8_BAR;
            PG8_LDA(At, 1, 1); PG8_STAGE(PG8_SA(1, 0), a3, voffA);
            PG8_BAR; PG8_WAIT_L(0); PG8_MMA(1, 0, At, B0); PG8_BAR; PG8_SCHED;
            PG8_STAGE(PG8_SB(1, 1), b3 + hstep, voffB);
            PG8_WAIT_V(6); PG8_BAR; PG8_MMA(1, 1, At, B1); PG8_BAR;
            }
        }
        if constexpr (ALIGN_EPI) { if (wr == 0) PG8_BAR; }
        if constexpr (!Epi::AFTER_DRAIN) { E(acc, cur, wr, wc, fr, fq); S.done(cur); }
        if (!has_next) break;
#pragma unroll
        for (int a = 0; a < 2; ++a)
#pragma unroll
            for (int b = 0; b < 2; ++b)
#pragma unroll
                for (int m = 0; m < 4; ++m)
#pragma unroll
                    for (int n = 0; n < 2; ++n) acc[a][b][m][n] = (f32x4){0.f, 0.f, 0.f, 0.f};
        cur = nxt; cA = nA; cB = nB; ++ui;
        if constexpr (ALIGN_EPI) { if (wr == 1) PG8_BAR; }
    }
    PG8_WAIT_V(0);
    if constexpr (!ALIGN_EPI) { if (wr == 0) PG8_BAR; }
    PG8_BAR;
    if constexpr (Epi::AFTER_DRAIN) { E.fused(acc, cur, wr, wc, fr, fq, lds, wid, lane); S.done(cur); }
#undef PG8_SA
#undef PG8_SB
#undef PG8_STAGE
#undef PG8_LDA
#undef PG8_LDB
#undef PG8_MMA
#undef PG8_WAIT_V
#undef PG8_WAIT_L
#undef PG8_BAR
#undef PG8_SCHED
}
}
namespace att {
typedef unsigned short bf16_t;
constexpr int   D = 128, NW = 8, QBLK = 32, KVBLK = 64;
constexpr float SCALE = 0.088388347648318440f;
constexpr float THR = 8.f;
constexpr int   LDQ = 128, LDK = 128, LDV2 = 256;
constexpr size_t SHM_V = KVBLK * D * 2, SHM_K = KVBLK * D * 2, SHM_ATTN = 2 * SHM_V + 2 * SHM_K + NW * 64 * 4;
using bf16x8 = __attribute__((ext_vector_type(8))) short;
using s16x4  = __attribute__((ext_vector_type(4))) short;
using f32x16 = __attribute__((ext_vector_type(16))) float;
using u32x4  = __attribute__((ext_vector_type(4))) unsigned;
#define KSWZ(row, colB) ((row) * 256 + ((colB) ^ (((row) & 7) << 4)))
#define SBAR() __builtin_amdgcn_sched_barrier(0)
__device__ __forceinline__ int crow(int r, int hi) { return (r & 3) + 8 * (r >> 2) + 4 * hi; }
typedef float f32x2a __attribute__((ext_vector_type(2))); typedef __bf16 bf16x2a __attribute__((ext_vector_type(2)));
__device__ __forceinline__ unsigned cvtpk(float lo, float hi) { f32x2a v = {lo, hi}; bf16x2a b = __builtin_convertvector(v, bf16x2a); return __builtin_bit_cast(unsigned, b); }
__device__ __forceinline__ bf16x8 ld8(const bf16_t* p) { return *reinterpret_cast<const bf16x8*>(p); }

template <bool WIN>
__device__ __forceinline__ void partialSM(f32x16& p0, f32x16& p1, float& m_reg, float& mn, float& alpha) {
  constexpr float C = SCALE * 1.4426950408889634f;
  float pmax = p0[0];
#pragma unroll
  for (int r = 1; r < 16; ++r) pmax = fmaxf(pmax, p0[r]);
#pragma unroll
  for (int r = 0; r < 16; ++r) pmax = fmaxf(pmax, p1[r]);
  { auto rr = __builtin_amdgcn_permlane32_swap(__float_as_uint(pmax), __float_as_uint(pmax), false, false);
    pmax = fmaxf(__uint_as_float(rr[0]), __uint_as_float(rr[1])); }
  if (__builtin_expect(__all(pmax - m_reg <= THR / SCALE), 1)) { mn = m_reg; alpha = 1.f; }
  else { mn = fmaxf(m_reg, pmax); alpha = __builtin_amdgcn_exp2f((m_reg - mn) * C); m_reg = mn; }
  float mnC = -mn * C;
#pragma unroll
  for (int r = 0; r < 16; ++r) p0[r] = fmaf(p0[r], C, mnC);
#pragma unroll
  for (int r = 0; r < 16; ++r) p1[r] = fmaf(p1[r], C, mnC);
#pragma unroll
  for (int r = 0; r < 16; ++r) p0[r] = __builtin_amdgcn_exp2f(p0[r]);
}
__device__ __forceinline__ void finishSM(f32x16& p0, f32x16& p1, float alpha, float& l_reg, bf16x8& pa0, bf16x8& pa1, bf16x8& pa2, bf16x8& pa3) {
#pragma unroll
  for (int r = 0; r < 16; ++r) p1[r] = __builtin_amdgcn_exp2f(p1[r]);
  float ps = 0;
#pragma unroll
  for (int r = 0; r < 16; ++r) ps += p0[r];
#pragma unroll
  for (int r = 0; r < 16; ++r) ps += p1[r];
  { auto rr = __builtin_amdgcn_permlane32_swap(__float_as_uint(ps), __float_as_uint(ps), false, false);
    ps = __uint_as_float(rr[0]) + __uint_as_float(rr[1]); }
  l_reg = l_reg * alpha + ps;
#define PK4(P, BASE, OUT) do { unsigned a0 = cvtpk(P[BASE + 0], P[BASE + 1]), a1 = cvtpk(P[BASE + 2], P[BASE + 3]);   \
    unsigned b0 = cvtpk(P[BASE + 4], P[BASE + 5]), b1 = cvtpk(P[BASE + 6], P[BASE + 7]);                              \
    auto r0 = __builtin_amdgcn_permlane32_swap(a0, b0, false, false); auto r1 = __builtin_amdgcn_permlane32_swap(a1, b1, false, false); \
    u32x4 w = {r0[0], r1[0], r0[1], r1[1]}; OUT = *reinterpret_cast<bf16x8*>(&w); } while (0)
  PK4(p0, 0, pa0); PK4(p0, 8, pa1); PK4(p1, 0, pa2); PK4(p1, 8, pa3);
#undef PK4
}
template <bool WIN>
__device__ __forceinline__ void qkt(f32x16& p0, f32x16& p1, const bf16_t* Ks, const bf16x8* qr, int r32, int hi, int dq) {
  p0 = f32x16{}; p1 = f32x16{};
  if (WIN) {
    const int t = 4 * hi - dq + 128;
#pragma unroll
    for (int r = 0; r < 16; ++r) { const unsigned d0 = (unsigned)(t + (r & 3) + 8 * (r >> 2)), d1 = d0 + 32u;
      p0[r] = d0 > 256u ? -1e30f : 0.f; p1[r] = d1 > 256u ? -1e30f : 0.f; }
  }
#pragma unroll
  for (int d0 = 0; d0 < 8; ++d0) { int cb = (d0 * 16 + hi * 8) * 2;
    bf16x8 b0 = *reinterpret_cast<const bf16x8*>((const char*)Ks + KSWZ(r32, cb));
    bf16x8 b1 = *reinterpret_cast<const bf16x8*>((const char*)Ks + KSWZ(32 + r32, cb));
    p0 = __builtin_amdgcn_mfma_f32_32x32x16_bf16(b0, qr[d0], p0, 0, 0, 0);
    p1 = __builtin_amdgcn_mfma_f32_32x32x16_bf16(b1, qr[d0], p1, 0, 0, 0); }
}
__device__ __forceinline__ int v_st(int k, int c) { const int kk = (k & ~0xC) | ((k & 4) << 1) | ((k & 8) >> 1); return ((kk >> 3) * 4 + (c >> 5)) * 512 + ((kk & 7) * 32 + (c & 31)) * 2; }
__device__ __forceinline__ int v_rd_base(int lane) { return ((lane & 3) << 3) | (((lane >> 2) & 3) << 6) | (((lane >> 4) & 1) << 5) | (((lane >> 5) & 1) << 8); }
constexpr int v_rd_off(int d0, int ks, int half) { return d0 * 512 + ks * 4096 + half * 2048; }
template <int OFF> __device__ __forceinline__ s16x4 tr_read(int vb) {
  s16x4 r; asm volatile("ds_read_b64_tr_b16 %0, %1 offset:%2" : "=&v"(r) : "v"(vb), "i"(OFF) : "memory"); return r;
}
template <int D0> __device__ __forceinline__ void pv_one(f32x16& od, int vb, bf16x8 pa0, bf16x8 pa1, bf16x8 pa2, bf16x8 pa3) {
  const s16x4 l0 = tr_read<v_rd_off(D0, 0, 0)>(vb), h0 = tr_read<v_rd_off(D0, 0, 1)>(vb), l1 = tr_read<v_rd_off(D0, 1, 0)>(vb), h1 = tr_read<v_rd_off(D0, 1, 1)>(vb);
  const s16x4 l2 = tr_read<v_rd_off(D0, 2, 0)>(vb), h2 = tr_read<v_rd_off(D0, 2, 1)>(vb), l3 = tr_read<v_rd_off(D0, 3, 0)>(vb), h3 = tr_read<v_rd_off(D0, 3, 1)>(vb);
  asm volatile("s_waitcnt lgkmcnt(0)" ::: "memory"); SBAR();
#define PK(L, H) (bf16x8){L[0], L[1], L[2], L[3], H[0], H[1], H[2], H[3]}
  od = __builtin_amdgcn_mfma_f32_32x32x16_bf16(pa0, PK(l0, h0), od, 0, 0, 0);
  od = __builtin_amdgcn_mfma_f32_32x32x16_bf16(pa1, PK(l1, h1), od, 0, 0, 0);
  od = __builtin_amdgcn_mfma_f32_32x32x16_bf16(pa2, PK(l2, h2), od, 0, 0, 0);
  od = __builtin_amdgcn_mfma_f32_32x32x16_bf16(pa3, PK(l3, h3), od, 0, 0, 0);
#undef PK
}
__device__ __forceinline__ void pv_d0(f32x16* o, int vb, bf16x8 pa0, bf16x8 pa1, bf16x8 pa2, bf16x8 pa3) {
  pv_one<0>(o[0], vb, pa0, pa1, pa2, pa3); pv_one<1>(o[1], vb, pa0, pa1, pa2, pa3); pv_one<2>(o[2], vb, pa0, pa1, pa2, pa3); pv_one<3>(o[3], vb, pa0, pa1, pa2, pa3);
}

template <bool WIN, int LDO, bool PACK = false>
__device__ __forceinline__ void attn_unit(const bf16_t* __restrict__ Qb, const bf16_t* __restrict__ Kh, const bf16_t* __restrict__ Vh,
                                          bf16_t* __restrict__ Ob, int NT, int dq_base, float m_init, float l_init, char* lds, const float* sinkp = nullptr) {
  const int tid = threadIdx.x, wid = tid >> 6, lane = tid & 63, r32 = lane & 31, hi = lane >> 5;
  const int rowg = PACK ? (wid & 1) * QBLK : wid * QBLK, hsel = PACK ? (wid >> 1) : 0;
  if (PACK) m_init = sinkp[hsel] * (1.0f / SCALE);
  bf16_t* V_lds = (bf16_t*)lds; bf16_t* K_lds = (bf16_t*)(lds + 2 * SHM_V);
  float* ws = (float*)(lds + 2 * SHM_V + 2 * SHM_K) + wid * 64; float* li_l = ws; float* al_l = ws + 32;
  float m_reg = m_init, l_reg = l_init; f32x16 o[4] = {}; bf16x8 qr[8];
  const int dq0 = dq_base + rowg + r32;
  const bf16_t* Qw = Qb + (long)hsel * (16384L * 128) + (long)(rowg + r32) * LDQ + hi * 8;
#pragma unroll
  for (int d0 = 0; d0 < 8; ++d0) qr[d0] = ld8(Qw + d0 * 16);
  const int sr = tid >> 4, sc = (tid & 15) * 8, vst0 = v_st(sr, sc), vst1 = v_st(32 + sr, sc);
  const int vb0 = (int)(uintptr_t)V_lds + v_rd_base(lane);
  bf16x8 vsA0, vsA1, ksA0, ksA1, vsB0, vsB1, ksB0, ksB1;
  const unsigned goff = (unsigned)(sr * LDK + sc) * 2u;
#define GLD(base, k0, extra) (*reinterpret_cast<const bf16x8*>((const char*)(base) + (size_t)(k0) * (LDK * 2) + (extra) + goff))
#define SLOAD_A(k0) do { vsA0 = GLD(Vh, k0, 0); vsA1 = GLD(Vh, k0, 32 * LDK * 2); ksA0 = GLD(Kh, k0, 0); ksA1 = GLD(Kh, k0, 32 * LDK * 2); } while (0)
#define SLOAD_B(k0) do { vsB0 = GLD(Vh, k0, 0); vsB1 = GLD(Vh, k0, 32 * LDK * 2); ksB0 = GLD(Kh, k0, 0); ksB1 = GLD(Kh, k0, 32 * LDK * 2); } while (0)
#define SWRITE_A() do { *(bf16x8*)((char*)V_lds + vst0) = vsA0; *(bf16x8*)((char*)V_lds + vst1) = vsA1; const int kc = sc * 2; \
    *(bf16x8*)((char*)K_lds + KSWZ(sr, kc)) = ksA0; *(bf16x8*)((char*)K_lds + KSWZ(32 + sr, kc)) = ksA1; } while (0)
#define SWRITE_B() do { *(bf16x8*)((char*)V_lds + SHM_V + vst0) = vsB0; *(bf16x8*)((char*)V_lds + SHM_V + vst1) = vsB1; const int kc = sc * 2; \
    *(bf16x8*)((char*)K_lds + SHM_K + KSWZ(sr, kc)) = ksB0; *(bf16x8*)((char*)K_lds + SHM_K + KSWZ(32 + sr, kc)) = ksB1; } while (0)
#define SWAIT() asm volatile("s_waitcnt vmcnt(4)" ::: "memory")
#define RESC(a) do { if (__any((a) < 1.f)) { if (hi == 0) al_l[r32] = (a); asm volatile("s_waitcnt lgkmcnt(0)" ::: "memory"); \
    _Pragma("unroll") for (int d = 0; d < 4; ++d) _Pragma("unroll") for (int r = 0; r < 16; ++r) o[d][r] *= al_l[crow(r, hi)]; } } while (0)
  f32x16 pA0, pA1, pB0, pB1; float mnA, mnB, alA, alB; bf16x8 pa0, pa1, pa2, pa3;
  SLOAD_A(0); asm volatile("s_waitcnt vmcnt(0)" ::: "memory"); SWRITE_A(); __syncthreads();
  qkt<WIN>(pA0, pA1, K_lds, qr, r32, hi, dq0); partialSM<WIN>(pA0, pA1, m_reg, mnA, alA);
  SLOAD_B(KVBLK); if (2 < NT) SLOAD_A(2 * KVBLK);
  SWAIT(); SWRITE_B(); __syncthreads();
  for (int j = 1; j + 1 < NT; j += 2) {
    SBAR(); qkt<WIN>(pB0, pB1, (bf16_t*)((char*)K_lds + SHM_K), qr, r32, hi, dq0 - j * KVBLK);
    finishSM(pA0, pA1, alA, l_reg, pa0, pa1, pa2, pa3); SBAR();
    SLOAD_B((j + 2) * KVBLK); SBAR();
    pv_d0(o, vb0, pa0, pa1, pa2, pa3); partialSM<WIN>(pB0, pB1, m_reg, mnB, alB);
    __syncthreads(); SWAIT(); SWRITE_A();
    RESC(alB); __syncthreads();
    SBAR(); qkt<WIN>(pA0, pA1, K_lds, qr, r32, hi, dq0 - (j + 1) * KVBLK);
    finishSM(pB0, pB1, alB, l_reg, pa0, pa1, pa2, pa3); SBAR();
    if (j + 3 < NT) SLOAD_A((j + 3) * KVBLK); SBAR();
    pv_d0(o, vb0 + (int)SHM_V, pa0, pa1, pa2, pa3); partialSM<WIN>(pA0, pA1, m_reg, mnA, alA);
    __syncthreads(); SWAIT(); SWRITE_B();
    RESC(alA); __syncthreads();
  }
  SBAR(); qkt<WIN>(pB0, pB1, (bf16_t*)((char*)K_lds + SHM_K), qr, r32, hi, dq0 - (NT - 1) * KVBLK);
  finishSM(pA0, pA1, alA, l_reg, pa0, pa1, pa2, pa3); SBAR();
  pv_d0(o, vb0, pa0, pa1, pa2, pa3); partialSM<WIN>(pB0, pB1, m_reg, mnB, alB);
  __syncthreads(); RESC(alB);
  finishSM(pB0, pB1, alB, l_reg, pa0, pa1, pa2, pa3); SBAR();
  pv_d0(o, vb0 + (int)SHM_V, pa0, pa1, pa2, pa3);
  if (hi == 0) li_l[r32] = l_reg; asm volatile("s_waitcnt lgkmcnt(0)" ::: "memory");
  float rli[16];
#pragma unroll
  for (int r = 0; r < 16; ++r) rli[r] = __builtin_amdgcn_rcpf(li_l[crow(r, hi)]);
  bf16_t* Ow = Ob + (long)rowg * LDO + hsel * 128;
#pragma unroll
  for (int r = 0; r < 16; ++r) { const int orow = crow(r, hi);
#pragma unroll
    for (int d0 = 0; d0 < 4; ++d0) Ow[(long)orow * LDO + d0 * 32 + r32] = (bf16_t)(cvtpk(o[d0][r] * rli[r], 0.f) & 0xffffu); }
  __syncthreads();
#undef SLOAD_A
#undef GLD
#undef SLOAD_B
#undef SWRITE_A
#undef SWRITE_B
#undef SWAIT
#undef RESC
}

#define LAS3 __attribute__((address_space(3)))
constexpr int DV_K0 = 0, DV_V0 = 32768, DV_WS = 98304, DV_LDS = DV_WS + NW * 256;
__device__ __forceinline__ void dma16(const void* g, LAS3 unsigned char* l) { __builtin_amdgcn_global_load_lds((const unsigned*)g, (LAS3 unsigned*)l, 16, 0, 0); }
template <int LDO>
__device__ __forceinline__ void attn_unit_dv(const bf16_t* __restrict__ Qb, const bf16_t* __restrict__ Kh, const bf16_t* __restrict__ Vh, bf16_t* __restrict__ Ob, int NT, char* lds, LAS3 unsigned char* ldsl) {
  const int tid = threadIdx.x, lane = tid & 63, r32 = lane & 31, hi = lane >> 5; const int wid = __builtin_amdgcn_readfirstlane(tid >> 6);
  float* ws = (float*)(lds + DV_WS) + wid * 64; float* li_l = ws; float* al_l = ws + 32;
  float m_reg = -1e30f, l_reg = 0.f; f32x16 o[8] = {}; bf16x8 qr[8];
  const unsigned koff0 = (unsigned)((8 * wid + (lane >> 4)) * (LDK * 2) + (((lane & 15) ^ (lane >> 4)) << 4));
  const int hf = wid >> 2;
  unsigned voff0;
  { const int lc = (4 * wid) & 15, b = lc * 1024 + 16 * lane, sub = b >> 9, e = (b & 511) >> 1;
    const int kk = (sub >> 2) * 8 + (e >> 5), c = (sub & 3) * 32 + (e & 31), k = (kk & ~0xC) | ((kk & 4) << 1) | ((kk & 8) >> 1);
    voff0 = (unsigned)(k * (LDV2 * 2) + (hf * 128 + c) * 2); }
  LAS3 unsigned char* kdst = ldsl + DV_K0 + wid * 2048;
  LAS3 unsigned char* vdst = ldsl + DV_V0 + hf * 16384 + ((4 * wid) & 15) * 1024;
#define DMA_KV(t, buf) do { const char* kb_ = (const char*)Kh + (size_t)(t) * (64 * LDK * 2); const char* vb_ = (const char*)Vh + (size_t)(t) * (64 * LDV2 * 2); \
    dma16(kb_ + koff0, kdst + (buf) * 16384); dma16(kb_ + 4 * (LDK * 2) + (koff0 ^ 64u), kdst + (buf) * 16384 + 1024); \
    dma16(vb_ + voff0, vdst + (buf) * 32768); dma16(vb_ + 128 + voff0, vdst + (buf) * 32768 + 1024); \
    dma16(vb_ + 4 * (LDV2 * 2) + voff0, vdst + (buf) * 32768 + 2048); dma16(vb_ + 4 * (LDV2 * 2) + 128 + voff0, vdst + (buf) * 32768 + 3072); } while (0)
#define RESC8(a) do { if (__any((a) < 1.f)) { if (hi == 0) al_l[r32] = (a); asm volatile("s_waitcnt lgkmcnt(0)" ::: "memory"); \
    _Pragma("unroll") for (int d = 0; d < 8; ++d) _Pragma("unroll") for (int r = 0; r < 16; ++r) o[d][r] *= al_l[crow(r, hi)]; } } while (0)
  if (wid >= 4) __builtin_amdgcn_s_setprio(1);
  DMA_KV(0, 0);
  const bf16_t* Qw = Qb + (long)(wid * QBLK + r32) * LDQ + hi * 8;
#pragma unroll
  for (int d0 = 0; d0 < 8; ++d0) qr[d0] = ld8(Qw + d0 * 16);
  const int vb0 = (int)(uintptr_t)(lds + DV_V0) + v_rd_base(lane);
  asm volatile("s_waitcnt vmcnt(0) lgkmcnt(0)" ::: "memory"); __builtin_amdgcn_s_barrier(); asm volatile("" ::: "memory");
  for (int t = 0; t < NT; ++t) {
    const int buf = t & 1;
    f32x16 p0, p1; float mn, alpha; bf16x8 pa0, pa1, pa2, pa3;
    qkt<false>(p0, p1, (const bf16_t*)(lds + DV_K0 + buf * 16384), qr, r32, hi, 0);
    SBAR();
    if (t + 1 < NT) DMA_KV(t + 1, buf ^ 1);
    SBAR();
    partialSM<false>(p0, p1, m_reg, mn, alpha);
    finishSM(p0, p1, alpha, l_reg, pa0, pa1, pa2, pa3);
    RESC8(alpha);
    SBAR();
    pv_d0(o, vb0 + buf * 32768, pa0, pa1, pa2, pa3);
    pv_d0(o + 4, vb0 + buf * 32768 + 16384, pa0, pa1, pa2, pa3);
    asm volatile("s_waitcnt vmcnt(0) lgkmcnt(0)" ::: "memory"); __builtin_amdgcn_s_barrier(); asm volatile("" ::: "memory");
  }
  __builtin_amdgcn_s_setprio(0);
  if (hi == 0) li_l[r32] = l_reg; asm volatile("s_waitcnt lgkmcnt(0)" ::: "memory");
  float rli[16];
#pragma unroll
  for (int r = 0; r < 16; ++r) rli[r] = __builtin_amdgcn_rcpf(li_l[crow(r, hi)]);
  bf16_t* Ow = Ob + (long)(wid * QBLK) * LDO;
#pragma unroll
  for (int r = 0; r < 16; ++r) { const int orow = crow(r, hi);
#pragma unroll
    for (int d0 = 0; d0 < 8; ++d0) Ow[(long)orow * LDO + d0 * 32 + r32] = (bf16_t)(cvtpk(o[d0][r] * rli[r], 0.f) & 0xffffu); }
#undef DMA_KV
#undef RESC8
}
#undef KSWZ
#undef SBAR
}

#define GAS __attribute__((address_space(1)))
#define LAS __attribute__((address_space(3)))
typedef unsigned short bf16;
typedef unsigned v4u __attribute__((ext_vector_type(4)));
typedef float f32x4 __attribute__((ext_vector_type(4)));

constexpr int NWAVES = 8;
constexpr int M = 32768, DM = 2048, FF = 5632, SEQ = 16384, WIN_COLS = 8704;
constexpr float EPS = 1e-6f;
constexpr size_t MiB = 1u << 20;
constexpr size_t WS_W1GU = 0, WS_W1D = 44 * MiB, WS_W2GU = 66 * MiB, WS_W2D = 110 * MiB, WS_WIN = 132 * MiB, WS_WPA = 166 * MiB, WS_WPB = 170 * MiB, WS_WOUT = 174 * MiB;
constexpr size_t WS_COS = 182 * MiB, WS_SIN = 186 * MiB;
constexpr size_t WS_B = 190 * MiB;
constexpr size_t WS_C = 318 * MiB;
constexpr size_t WS_D = 446 * MiB;
constexpr size_t WS_CTL = 990 * MiB, CTL_BYTES = 65536;
constexpr size_t WS_END = 991 * MiB;
constexpr int LDS_BYTES = 134 * 1024;
constexpr int NPHASE = 14;
#ifndef MK_PER_PHASE
#define MK_PER_PHASE 0
#endif
#ifndef PH_LIMIT
#define PH_LIMIT NPHASE
#endif

__device__ __forceinline__ unsigned f2bf(float f) { unsigned u = __builtin_bit_cast(unsigned, f); return (u + 0x7fffu + ((u >> 16) & 1u)) >> 16; }
__device__ __forceinline__ unsigned pk2(float lo, float hi) { return pg8::cvt_pk_bf16(lo, hi); }
__device__ __forceinline__ float wave_sum(float v) {
#pragma unroll
    for (int o = 1; o < 64; o <<= 1) v += __shfl_xor(v, o);
    return v;
}
__device__ __forceinline__ void transpose_item(const float* W, int K, int N, bf16* WT, int dst_row0, int k0, int n0, LAS float* scr, int lane) {
    { const int rr = lane >> 3, c4 = (lane & 7) * 4;
      f32x4 t[8];
#pragma unroll
      for (int i = 0; i < 8; ++i) t[i] = *(const f32x4*)(W + (size_t)(k0 + 8 * i + rr) * N + n0 + c4);
#pragma unroll
      for (int i = 0; i < 8; ++i) { LAS float* d = scr + (8 * i + rr) * 33 + c4; d[0] = t[i][0]; d[1] = t[i][1]; d[2] = t[i][2]; d[3] = t[i][3]; } }
    asm volatile("s_waitcnt lgkmcnt(0)" ::: "memory");
    const int c = lane & 7;
#pragma unroll
    for (int j = 0; j < 4; ++j) { const int n = (lane >> 3) + 8 * j; const LAS float* s = scr + (8 * c) * 33 + n;
        v4u o; o.x = pk2(s[0 * 33], s[1 * 33]); o.y = pk2(s[2 * 33], s[3 * 33]); o.z = pk2(s[4 * 33], s[5 * 33]); o.w = pk2(s[6 * 33], s[7 * 33]);
        *(v4u*)(WT + (size_t)(dst_row0 + n) * K + k0 + 8 * c) = o; }
    asm volatile("s_waitcnt lgkmcnt(0)" ::: "memory");
}
__device__ __forceinline__ int win_row(int n0) {
    const int pn = n0 >> 8; const bool rope = (pn <= 4) || (pn >= 6 && pn <= 13);
    if (!rope) return n0;
    const int rem = n0 & 255; return (pn << 8) + (((rem & 127) >> 6) << 7) + ((rem >> 7) << 6) + (rem & 63);
}
__device__ __forceinline__ void ld_row_f32(const float* p, int lane, f32x4 (&v)[8]) {
#pragma unroll
    for (int j = 0; j < 4; ++j) { const f32x4* q = (const f32x4*)(p + 8 * (lane + 64 * j)); v[2 * j] = q[0]; v[2 * j + 1] = q[1]; }
}
__device__ __forceinline__ void st_row_f32(float* p, int lane, const f32x4 (&v)[8]) {
#pragma unroll
    for (int j = 0; j < 4; ++j) { f32x4* q = (f32x4*)(p + 8 * (lane + 64 * j)); q[0] = v[2 * j]; q[1] = v[2 * j + 1]; }
}
__device__ __forceinline__ void ld_row_bf16(const bf16* p, int lane, f32x4 (&v)[8]) {
#pragma unroll
    for (int j = 0; j < 4; ++j) { const v4u w = *(const v4u*)(p + 8 * (lane + 64 * j));
        v[2 * j] = (f32x4){pg8::bf_lo(w.x), pg8::bf_hi(w.x), pg8::bf_lo(w.y), pg8::bf_hi(w.y)}; v[2 * j + 1] = (f32x4){pg8::bf_lo(w.z), pg8::bf_hi(w.z), pg8::bf_lo(w.w), pg8::bf_hi(w.w)}; }
}
__device__ __forceinline__ void st_row_bf16(bf16* p, int lane, const f32x4 (&v)[8]) {
#pragma unroll
    for (int j = 0; j < 4; ++j) { v4u w; w.x = pk2(v[2 * j][0], v[2 * j][1]); w.y = pk2(v[2 * j][2], v[2 * j][3]); w.z = pk2(v[2 * j + 1][0], v[2 * j + 1][1]); w.w = pk2(v[2 * j + 1][2], v[2 * j + 1][3]);
        *(v4u*)(p + 8 * (lane + 64 * j)) = w; }
}
__device__ __forceinline__ float row_rstd(const f32x4 (&v)[8]) {
    float s = 0.f;
#pragma unroll
    for (int j = 0; j < 8; ++j) s += (v[j][0] * v[j][0] + v[j][1] * v[j][1]) + (v[j][2] * v[j][2] + v[j][3] * v[j][3]);
    return __builtin_amdgcn_rsqf(wave_sum(s) * (1.0f / DM) + EPS);
}
__device__ __forceinline__ void ld_row_raw(const bf16* p, int lane, v4u (&w)[4]) {
#pragma unroll
    for (int j = 0; j < 4; ++j) w[j] = *(const v4u*)(p + 8 * (lane + 64 * j));
}
__device__ __forceinline__ void unpack_row(const v4u (&w)[4], f32x4 (&v)[8]) {
#pragma unroll
    for (int j = 0; j < 4; ++j) { v[2 * j] = (f32x4){pg8::bf_lo(w[j].x), pg8::bf_hi(w[j].x), pg8::bf_lo(w[j].y), pg8::bf_hi(w[j].y)}; v[2 * j + 1] = (f32x4){pg8::bf_lo(w[j].z), pg8::bf_hi(w[j].z), pg8::bf_lo(w[j].w), pg8::bf_hi(w[j].w)}; }
}
template <bool BB, bool OB>
__device__ __forceinline__ void residual_rows(const bf16* F, const void* basev, void* outv, const float* g_post, float alpha, const float* g_next, bf16* XN, int gw, int NGW, int lane) {
    const char* base = (const char*)basev; char* out = (char*)outv;
    v4u fw[4], bw[4]; f32x4 b[8];
    f32x4 gp[8], gn[8];
    ld_row_f32(g_post, lane, gp); if (XN) ld_row_f32(g_next, lane, gn);
    int m = gw;
    if (m < M) { ld_row_raw(F + (size_t)m * DM, lane, fw);
        if (BB) ld_row_raw((const bf16*)(base + (size_t)m * 8192), lane, bw); else ld_row_f32((const float*)(base + (size_t)m * 8192), lane, b); }
    for (; m < M; m += NGW) {
        const int mn = m + NGW; const bool more = mn < M;
        v4u fwn[4], bwn[4]; f32x4 bn[8];
        if (more) { ld_row_raw(F + (size_t)mn * DM, lane, fwn);
            if (BB) ld_row_raw((const bf16*)(base + (size_t)mn * 8192), lane, bwn); else ld_row_f32((const float*)(base + (size_t)mn * 8192), lane, bn); }
        f32x4 f[8];
        unpack_row(fw, f); if (BB) unpack_row(bw, b);
        const float r1 = row_rstd(f) * alpha;
#pragma unroll
        for (int j = 0; j < 8; ++j) b[j] = b[j] + f[j] * r1 * gp[j];
        if (OB) st_row_bf16((bf16*)(out + (size_t)m * 8192), lane, b); else st_row_f32((float*)(out + (size_t)m * 8192), lane, b);
        if (XN) { const float r2 = row_rstd(b);
#pragma unroll
            for (int j = 0; j < 8; ++j) b[j] = b[j] * r2 * gn[j];
            st_row_bf16(XN + (size_t)m * DM, lane, b); }
        if (more) {
#pragma unroll
            for (int j = 0; j < 4; ++j) { fw[j] = fwn[j]; if (BB) bw[j] = bwn[j]; }
            if (!BB) {
#pragma unroll
                for (int j = 0; j < 8; ++j) b[j] = bn[j]; } }
    }
}

#define XB_TMO      128
#define XB_XCNT(j)  (256  + 64 * (j))
#define XB_XSUB(j)  (1280 + 64 * (j))
#define XB_XGEN(j)  (2304 + 64 * (j))
#define XB_TOP      3328
#define XB_TOPGEN   3392
#define XCD_BAR_WORDS 3456
#define XB_SPIN_CAP (1u << 18)

__device__ __forceinline__ unsigned xb_ld(unsigned* p)              { return __hip_atomic_load(p, __ATOMIC_RELAXED, __HIP_MEMORY_SCOPE_AGENT); }
__device__ __forceinline__ unsigned xb_add(unsigned* p, unsigned v) { return __hip_atomic_fetch_add(p, v, __ATOMIC_RELAXED, __HIP_MEMORY_SCOPE_AGENT); }
__device__ __forceinline__ unsigned xb_xcc_id() { return (unsigned)__builtin_amdgcn_s_getreg((3 << 11) | 20) & 0xFu; }
#define XB_SPIN(cond, bar) do { unsigned _sp = 0; while (cond) { __builtin_amdgcn_s_sleep(1); \
    if ((++_sp & 255u) == 0u) { if (xb_ld(&(bar)[XB_TMO])) break; if (_sp > XB_SPIN_CAP) { atomicAdd(&(bar)[XB_TMO], 1u); break; } } } } while (0)

struct XcdBarrier {
    unsigned* bar; unsigned x;
    volatile LAS unsigned* st;
};

__device__ __forceinline__ XcdBarrier xcd_barrier_post(unsigned* bar, volatile LAS unsigned* st) {
    XcdBarrier b; b.bar = bar; b.x = xb_xcc_id(); b.st = st;
    if (threadIdx.x == 0) (void)xb_add(&bar[XB_XCNT(b.x)], 1u);
    return b;
}
__device__ __forceinline__ void xcd_barrier_complete(unsigned* bar, unsigned x, unsigned& nloc, unsigned& nx) {
    const unsigned G = gridDim.x * gridDim.y * gridDim.z;
    unsigned sum, cnt, mine, sp = 0u;
    for (;;) {
        sum = 0u; cnt = 0u; mine = 0u;
#pragma unroll
        for (unsigned j = 0; j < 16; ++j) { const unsigned c = xb_ld(&bar[XB_XCNT(j)]); sum += c; cnt += (c > 0u) ? 1u : 0u; mine = (j == x) ? c : mine; }
        if (sum == G) break;
        __builtin_amdgcn_s_sleep(1);
        if ((++sp & 255u) == 0u) { if (xb_ld(&bar[XB_TMO])) break; if (sp > XB_SPIN_CAP) { atomicAdd(&bar[XB_TMO], 1u); break; } }
    }
    nloc = mine > 0u ? mine : 1u; nx = cnt > 0u ? cnt : 1u;
}

__device__ __forceinline__ void xcd_barrier(const XcdBarrier& b) {
    asm volatile("s_waitcnt vmcnt(0)" ::: "memory");
    __syncthreads();
    if (threadIdx.x == 0) {
        unsigned* bar = b.bar;
        __builtin_amdgcn_s_waitcnt(0);
        unsigned nloc = b.st[0], nx = b.st[1];
        if (nloc == 0u) { xcd_barrier_complete(bar, b.x, nloc, nx); b.st[0] = nloc; b.st[1] = nx; }
        const unsigned old = xb_add(&bar[XB_XSUB(b.x)], 1u);
        const unsigned gen = old / nloc;
        if (old + 1u == (gen + 1u) * nloc) {
            __builtin_amdgcn_fence(__ATOMIC_RELEASE, "agent");
            asm volatile("s_waitcnt vmcnt(0)" ::: "memory");
            const unsigned og = xb_add(&bar[XB_TOP], 1u);
            const unsigned tg = og / nx;
            if (og + 1u == (tg + 1u) * nx) xb_add(&bar[XB_TOPGEN], 1u);
            else XB_SPIN(xb_ld(&bar[XB_TOPGEN]) == tg, bar);
            __builtin_amdgcn_fence(__ATOMIC_ACQUIRE, "agent");
            xb_add(&bar[XB_XGEN(b.x)], 1u);
            asm volatile("s_waitcnt vmcnt(0)" ::: "memory");
        } else {
            XB_SPIN(xb_ld(&bar[XB_XGEN(b.x)]) == gen, bar);
            __builtin_amdgcn_fence(__ATOMIC_ACQUIRE, "agent");
            asm volatile("s_waitcnt vmcnt(0)" ::: "memory");
        }
    }
    __syncthreads();
}

struct Args { const float* in[24]; float* out; unsigned char* ws; int ph_lo, ph_hi; };

__global__ void __launch_bounds__(NWAVES * 64, 2) mk_fwd(Args args) {
    extern __shared__ __attribute__((aligned(16))) unsigned char lds[];
    cg::grid_group grid = cg::this_grid();
    const int tid = threadIdx.x, lane = tid & 63, wave = __builtin_amdgcn_readfirstlane(tid >> 6);
    const int G = gridDim.x, bx = blockIdx.x, vcu = (G % 8 == 0) ? (bx % 8) * (G / 8) + bx / 8 : bx;
    const int gw = vcu * NWAVES + wave, NGW = G * NWAVES;
    unsigned char* ws = args.ws;
    const float* x = args.in[0]; float* out = args.out;
    bf16* W1GU = (bf16*)(ws + WS_W1GU); bf16* W1D = (bf16*)(ws + WS_W1D); bf16* W2GU = (bf16*)(ws + WS_W2GU); bf16* W2D = (bf16*)(ws + WS_W2D);
    bf16* WIN = (bf16*)(ws + WS_WIN); bf16* WPA = (bf16*)(ws + WS_WPA); bf16* WPB = (bf16*)(ws + WS_WPB); bf16* WOUT = (bf16*)(ws + WS_WOUT);
    float* cosT = (float*)(ws + WS_COS); float* sinT = (float*)(ws + WS_SIN);
    bf16* RB = (bf16*)(ws + WS_B); bf16* RC = (bf16*)(ws + WS_C); bf16* RD = (bf16*)(ws + WS_D);
    bf16* OA = RB; bf16* OB = RB + (size_t)M * 1024;
    bf16* GA = RD; bf16* GB = RD + (size_t)64 * MiB; bf16* QB = RD + (size_t)128 * MiB; bf16* KB = RD + (size_t)160 * MiB; bf16* VB = RD + (size_t)192 * MiB;
    bf16* QA = RD + (size_t)224 * MiB; bf16* KA = RD + (size_t)256 * MiB; bf16* VA = RD + (size_t)264 * MiB;
    LAS unsigned char* ldsl = (LAS unsigned char*)lds;
    const int lo = args.ph_lo, hi = args.ph_hi;
    volatile LAS unsigned* bst = (volatile LAS unsigned*)(ldsl + 133120 + 64);
    if (tid < 2) bst[tid] = 0u;
    __syncthreads();
    XcdBarrier bar = xcd_barrier_post((unsigned*)(ws + WS_CTL), bst);
    if (lo == 0 && hi > 1) grid.sync();
#ifndef PH_MASK
#define PH_MASK 0x3fff
#endif
#define IN(k) (((PH_MASK >> (k)) & 1) && lo <= (k) && (k) < hi)
#ifndef ATT_REP
#define ATT_REP 1
#endif
#ifndef PROBE_TWICE
#define PROBE_TWICE 0
#endif
#define REP(k) for (int rep_ = 0; rep_ < 1 + ((PROBE_TWICE >> (k)) & 1); ++rep_)
#define SEAM(k) do { if (IN(k) && IN((k) + 1)) xcd_barrier(bar); } while (0)

    if (IN(0)) REP(0) {
        LAS float* scr = (LAS float*)(ldsl + wave * 16384);
        constexpr int C_GU = (DM / 64) * (FF / 32), C_D = (FF / 64) * (DM / 32), C_IN = (DM / 64) * (WIN_COLS / 32), C_P = (1024 / 64) * (DM / 32), C_O = (DM / 64) * (DM / 32);
        constexpr int NITEMS = 4 * C_GU + 2 * C_D + C_IN + 2 * C_P + C_O;
        for (int it = gw; it < NITEMS; it += NGW) {
            int r = it;
#define TR_MAT(SRC, KK, NN, DST, CNT, ROWEXPR) if (r < (CNT)) { const int nblk = (NN) / 32, kb = r / nblk, n0 = (r % nblk) * 32; transpose_item(SRC, KK, NN, DST, (ROWEXPR), kb * 64, n0, scr, lane); continue; } r -= (CNT);
            TR_MAT(args.in[2], DM, FF, W1GU, C_GU, 256 * (n0 >> 7) + (n0 & 127))
            TR_MAT(args.in[3], DM, FF, W1GU, C_GU, 256 * (n0 >> 7) + 128 + (n0 & 127))
            TR_MAT(args.in[4], FF, DM, W1D, C_D, n0)
            TR_MAT(args.in[20], DM, FF, W2GU, C_GU, 256 * (n0 >> 7) + (n0 & 127))
            TR_MAT(args.in[21], DM, FF, W2GU, C_GU, 256 * (n0 >> 7) + 128 + (n0 & 127))
            TR_MAT(args.in[22], FF, DM, W2D, C_D, n0)
            TR_MAT(args.in[7], DM, WIN_COLS, WIN, C_IN, win_row(n0))
            TR_MAT(args.in[15], 1024, DM, WPA, C_P, n0)
            TR_MAT(args.in[16], 1024, DM, WPB, C_P, n0)
            TR_MAT(args.in[17], DM, DM, WOUT, C_O, n0)
#undef TR_MAT
        }
        for (int idx = (vcu * NWAVES * 64 + tid); idx < SEQ * 64; idx += G * NWAVES * 64) {
            const int pos = idx >> 6, i = idx & 63;
            const double inv = exp(-(double)(2 * i) / 128.0 * 9.210340371976184);
            double s, c; sincos((double)pos * inv, &s, &c);
            cosT[idx] = (float)c; sinT[idx] = (float)s;
        }
        f32x4 g[8]; ld_row_f32(args.in[1], lane, g);
        for (int m = gw; m < M; m += NGW) {
            f32x4 v[8]; ld_row_f32(x + (size_t)m * DM, lane, v);
            const float r = row_rstd(v);
#pragma unroll
            for (int j = 0; j < 8; ++j) v[j] = v[j] * r * g[j];
            st_row_bf16(RB + (size_t)m * DM, lane, v);
        }
    }
    SEAM(0);
    if (IN(1)) REP(1) { pg8::Gemm g{RB, W1GU, M, 2 * FF, DM}; pg8::StaticOrder S; S.init(M, 2 * FF, G, bx); pg8::EpiSwiGLU E{RD, FF};
        pg8::gemm_phase<pg8::EpiSwiGLU, pg8::StaticOrder, true, true>(ldsl, g, S, E); }
    SEAM(1);
    if (IN(2)) REP(2) { pg8::Gemm g{RD, W1D, M, DM, FF}; pg8::StaticOrder S; S.init(M, DM, G, bx); pg8::EpiStore E{RC, DM};
        pg8::gemm_phase<pg8::EpiStore, pg8::StaticOrder, true, true>(ldsl, g, S, E); }
    SEAM(2);
    if (IN(3)) REP(3) residual_rows<false, true>(RC, x, out, args.in[5], 0.5f, args.in[6], RB, gw, NGW, lane);
    SEAM(3);
    if (IN(4)) REP(4) { pg8::Gemm g{RB, WIN, M, WIN_COLS, DM}; pg8::StaticOrder S; S.init(M, WIN_COLS, G, bx); pg8::EpiProj E{QA, KA, VA, QB, KB, VB, GA, GB, cosT, sinT, args.in[8]};
        pg8::gemm_phase<pg8::EpiProj, pg8::StaticOrder, true, true>(ldsl, g, S, E); }
    SEAM(4);
    if (IN(5)) REP(5) {

#ifndef NO_DENSE
        for (int id2 = vcu; id2 < 1024 * ATT_REP; id2 += G) { const int id = id2 & 1023;
            const int combo = id >> 6, qb = id & 63, b = combo >> 3, h = (combo >> 1) & 3, c = combo & 1;
            const bf16* Q = QB + ((size_t)(b * 8 + h * 2 + c) * SEQ + qb * 256) * 128;
            const bf16* K = KB + ((size_t)(b * 8 + h * 2 + c) * SEQ) * 128;
            const bf16* V = VB + ((size_t)(b * 4 + h) * SEQ) * 256;
            bf16* O = RC + (size_t)(b * SEQ + qb * 256) * 2048 + h * 512 + c * 256;
            att::attn_unit_dv<2048>(Q, K, V, O, SEQ / 64, (char*)lds, ldsl);
        }
#endif
#ifndef NO_WIN
        for (int id = vcu; id < 1024; id += G) {
            const int qb = id & 255, g = (id >> 8) & 1, b = id >> 9, q0 = qb * 64;
            int klo = q0 >= 128 ? q0 - 128 : 0, khi = (q0 + 192 <= SEQ) ? q0 + 192 : SEQ;
            if (((khi - klo) >> 6) & 1) { if (khi + 64 <= SEQ) khi += 64; else klo -= 64; }
            const bf16* Q = QA + ((size_t)(b * 8 + 4 * g) * SEQ + q0) * 128;
            const bf16* K = KA + ((size_t)(b * 2 + g) * SEQ + klo) * 128;
            const bf16* V = VA + ((size_t)(b * 2 + g) * SEQ + klo) * 128;
            bf16* O = OA + (size_t)(b * SEQ + q0) * 1024 + 4 * g * 128;
            att::attn_unit<true, 1024, true>(Q, K, V, O, (khi - klo) / 64, q0 - klo, 0.f, 1.f, (char*)lds, args.in[9] + 4 * g);
        }
#endif
    }
    SEAM(5);
    if (IN(6)) REP(6) {
        const float a1 = wave_sum(args.in[10][lane] * args.in[11][lane] + args.in[10][lane + 64] * args.in[11][lane + 64]);
        const float a2 = wave_sum(args.in[12][lane] * args.in[13][lane] + args.in[12][lane + 64] * args.in[13][lane + 64]);
        const float lam = expf(a1) - expf(a2) + 0.2f;
        const int h = lane >> 4, e0 = (lane & 15) * 16;
        f32x4 sg[4];
#pragma unroll
        for (int j = 0; j < 4; ++j) sg[j] = *(const f32x4*)(args.in[14] + e0 + 4 * j) * 0.8f;
        for (int m = gw; m < M; m += NGW) {
            const bf16* p = RC + (size_t)m * 2048 + h * 512 + e0;
            const v4u w0 = *(const v4u*)p, w1 = *(const v4u*)(p + 8), u0 = *(const v4u*)(p + 256), u1 = *(const v4u*)(p + 264);
            f32x4 d[4];
            d[0] = (f32x4){pg8::bf_lo(w0.x), pg8::bf_hi(w0.x), pg8::bf_lo(w0.y), pg8::bf_hi(w0.y)} - lam * (f32x4){pg8::bf_lo(u0.x), pg8::bf_hi(u0.x), pg8::bf_lo(u0.y), pg8::bf_hi(u0.y)};
            d[1] = (f32x4){pg8::bf_lo(w0.z), pg8::bf_hi(w0.z), pg8::bf_lo(w0.w), pg8::bf_hi(w0.w)} - lam * (f32x4){pg8::bf_lo(u0.z), pg8::bf_hi(u0.z), pg8::bf_lo(u0.w), pg8::bf_hi(u0.w)};
            d[2] = (f32x4){pg8::bf_lo(w1.x), pg8::bf_hi(w1.x), pg8::bf_lo(w1.y), pg8::bf_hi(w1.y)} - lam * (f32x4){pg8::bf_lo(u1.x), pg8::bf_hi(u1.x), pg8::bf_lo(u1.y), pg8::bf_hi(u1.y)};
            d[3] = (f32x4){pg8::bf_lo(w1.z), pg8::bf_hi(w1.z), pg8::bf_lo(w1.w), pg8::bf_hi(w1.w)} - lam * (f32x4){pg8::bf_lo(u1.z), pg8::bf_hi(u1.z), pg8::bf_lo(u1.w), pg8::bf_hi(u1.w)};
            float s = 0.f;
#pragma unroll
            for (int j = 0; j < 4; ++j) s += (d[j][0] * d[j][0] + d[j][1] * d[j][1]) + (d[j][2] * d[j][2] + d[j][3] * d[j][3]);
            s += __shfl_xor(s, 1); s += __shfl_xor(s, 2); s += __shfl_xor(s, 4); s += __shfl_xor(s, 8);
            const float r = 1.0f / sqrtf(s * (1.0f / 256.0f) + EPS);
#pragma unroll
            for (int j = 0; j < 4; ++j) d[j] = d[j] * r * sg[j];
            v4u o0, o1; o0.x = pk2(d[0][0], d[0][1]); o0.y = pk2(d[0][2], d[0][3]); o0.z = pk2(d[1][0], d[1][1]); o0.w = pk2(d[1][2], d[1][3]);
            o1.x = pk2(d[2][0], d[2][1]); o1.y = pk2(d[2][2], d[2][3]); o1.z = pk2(d[3][0], d[3][1]); o1.w = pk2(d[3][2], d[3][3]);
            bf16* q = OB + (size_t)m * 1024 + h * 256 + e0; *(v4u*)q = o0; *(v4u*)(q + 8) = o1;
        }
    }
    SEAM(6);
    if (IN(7)) REP(7) { pg8::Gemm g{OA, WPA, M, DM, 1024}; pg8::StaticOrder S; S.init(M, DM, G, bx); pg8::EpiGate<0> E{RC, GA};
        pg8::gemm_phase<pg8::EpiGate<0>, pg8::StaticOrder, true, true>(ldsl, g, S, E); }
    SEAM(7);
    if (IN(8)) REP(8) { pg8::Gemm g{OB, WPB, M, DM, 1024}; pg8::StaticOrder S; S.init(M, DM, G, bx); pg8::EpiGate<1> E{RC, GB};
        pg8::gemm_phase<pg8::EpiGate<1>, pg8::StaticOrder, true, true>(ldsl, g, S, E); }
    SEAM(8);
    if (IN(9)) REP(9) { pg8::Gemm g{RC, WOUT, M, DM, DM}; pg8::StaticOrder S; S.init(M, DM, G, bx); pg8::EpiStore E{RB, DM};
        pg8::gemm_phase<pg8::EpiStore, pg8::StaticOrder, true, true>(ldsl, g, S, E); }
    SEAM(9);
    if (IN(10)) REP(10) residual_rows<true, true>(RB, out, out, args.in[18], 1.0f, args.in[19], RC, gw, NGW, lane);
    SEAM(10);
    if (IN(11)) REP(11) { pg8::Gemm g{RC, W2GU, M, 2 * FF, DM}; pg8::StaticOrder S; S.init(M, 2 * FF, G, bx); pg8::EpiSwiGLU E{RD, FF};
        pg8::gemm_phase<pg8::EpiSwiGLU, pg8::StaticOrder, true, true>(ldsl, g, S, E); }
    SEAM(11);
    if (IN(12)) REP(12) { pg8::Gemm g{RD, W2D, M, DM, FF}; pg8::StaticOrder S; S.init(M, DM, G, bx); pg8::EpiStore E{RB, DM};
        pg8::gemm_phase<pg8::EpiStore, pg8::StaticOrder, true, true>(ldsl, g, S, E); }
    SEAM(12);
    if (IN(13)) REP(13) residual_rows<true, false>(RB, out, out, args.in[23], 0.5f, nullptr, nullptr, gw, NGW, lane);
#undef IN
#undef SEAM
}

extern "C" void kernel_launch(void* const* d_in, const int* in_sizes, int n_in, void* d_out, int out_size, void* d_ws, size_t ws_size, hipStream_t stream) {
    static int grid = 0;
    if (grid == 0) {
        if (n_in != 24 || in_sizes[0] != M * DM || out_size != M * DM || ws_size < WS_END) { fprintf(stderr, "kernel_launch: shape/workspace mismatch (n_in %d, in0 %d, out %d, ws %zu < %zu)\n", n_in, n_in > 0 ? in_sizes[0] : -1, out_size, ws_size, (size_t)WS_END); grid = -1; return; }
        int dev = 0, cus = 0, per_cu = 0;
        if (hipGetDevice(&dev) != hipSuccess || hipDeviceGetAttribute(&cus, hipDeviceAttributeMultiprocessorCount, dev) != hipSuccess) { grid = -1; return; }
        if (hipFuncSetAttribute((const void*)mk_fwd, hipFuncAttributeMaxDynamicSharedMemorySize, LDS_BYTES) != hipSuccess) { fprintf(stderr, "kernel_launch: hipFuncSetAttribute failed\n"); grid = -1; return; }
        if (hipOccupancyMaxActiveBlocksPerMultiprocessor(&per_cu, (const void*)mk_fwd, NWAVES * 64, LDS_BYTES) != hipSuccess || per_cu < 1) { fprintf(stderr, "kernel_launch: occupancy query says %d\n", per_cu); per_cu = 1; }
        (void)hipGetLastError();
        grid = cus * per_cu;
    }
    if (grid < 0) return;
    Args a{};
    for (int i = 0; i < 24; ++i) a.in[i] = (const float*)d_in[i];
    a.out = (float*)d_out; a.ws = (unsigned char*)d_ws;
#if MK_PER_PHASE
    for (int p = 0; p < PH_LIMIT; ++p) { a.ph_lo = p; a.ph_hi = p + 1; hipLaunchKernelGGL(mk_fwd, dim3(grid), dim3(NWAVES * 64), LDS_BYTES, stream, a); }
#else
    a.ph_lo = 0; a.ph_hi = NPHASE;
    if (hipMemsetAsync((char*)d_ws + WS_CTL, 0, CTL_BYTES, stream) != hipSuccess) { fprintf(stderr, "kernel_launch: memset failed\n"); return; }
    void* kargs[] = {&a};
    const hipError_t e = hipLaunchCooperativeKernel((const void*)mk_fwd, dim3(grid), dim3(NWAVES * 64), kargs, LDS_BYTES, stream);
    if (e != hipSuccess) fprintf(stderr, "kernel_launch: cooperative launch failed: %s (grid %d)\n", hipGetErrorString(e), grid);
#endif
}
```

```cpp
#include <hip/hip_runtime.h>
#include <hip/hip_bf16.h>
#include <hip/hip_cooperative_groups.h>
#include <cstdio>
#include <cstdint>
#include <cmath>
namespace cg = cooperative_groups;
namespace pg8 {
#define PG8_LAS __attribute__((address_space(3)))
typedef unsigned short bf16_t;
typedef short bf16x8 __attribute__((ext_vector_type(8)));
typedef float f32x4 __attribute__((ext_vector_type(4)));
typedef unsigned u32x4 __attribute__((ext_vector_type(4)));
constexpr int BM = 256, BK = 64, HALF = 128, HTB = HALF * BK * 2  , STAGE_BYTES = 8 * HTB, NXCD = 8, WGM = 8;

__host__ __device__ __forceinline__ int lds_byte(int r, int c) { const int st = (r >> 4) * 2 + (c >> 5), rr = r & 15, cc = c & 31, ob = rr * 64 + cc * 2; return st * 1024 + (ob ^ (((ob >> 9) & 1) << 5)); }
__host__ __device__ __forceinline__ void stage_rc(int b, int& R, int& C) { const int st = b / 1024, sb = b % 1024, swz = sb ^ (((sb >> 9) & 1) << 5); R = (st >> 1) * 16 + swz / 64; C = (st & 1) * 32 + (swz % 64) / 2; }
__host__ __device__ __forceinline__ int perm32(int rho) { const int n = rho >> 4, i = rho & 15; return 8 * (i >> 2) + 4 * n + (i & 3); }

struct Unit { int pm, pn; };
struct Gemm { const bf16_t* A; const bf16_t* Bt; int M, N, K; };

struct StaticOrder {
    int nM, nN, nwg, G, c;
    __host__ __device__ void init(int M, int N, int G_, int c_) { nM = M / BM; nN = N / BM; nwg = nM * nN; G = G_; c = c_; }
    __host__ __device__ bool next(int i, Unit& u) const {
        const long L = (long)i * G + c; if (L >= nwg) return false;
        int wgid = (int)L; { const int q = nwg / NXCD, r = nwg % NXCD, xcd = wgid % NXCD, off = wgid / NXCD; wgid = (xcd < r ? xcd * (q + 1) : r * (q + 1) + (xcd - r) * q) + off; }
        const int nig = WGM * nN, gid = wgid / nig, fm = gid * WGM, gsz = (nM - fm) < WGM ? (nM - fm) : WGM;
        u.pm = fm + ((wgid % nig) % gsz); u.pn = (wgid % nig) / gsz; return true;
    }
    __device__ __forceinline__ void a_ready(const Unit&) const {}
    __device__ __forceinline__ void done(const Unit&) const {}
};
typedef float f32x2_t __attribute__((ext_vector_type(2))); typedef __bf16 bf16x2_t __attribute__((ext_vector_type(2)));
__device__ __forceinline__ unsigned cvt_pk_bf16(float lo, float hi) { f32x2_t v = {lo, hi}; bf16x2_t b = __builtin_convertvector(v, bf16x2_t); return __builtin_bit_cast(unsigned, b); }
typedef float f32x2 __attribute__((ext_vector_type(2)));
__device__ __forceinline__ float bf_lo(unsigned w) { return __uint_as_float(w << 16); }
__device__ __forceinline__ float bf_hi(unsigned w) { return __uint_as_float(w & 0xffff0000u); }
__device__ __forceinline__ u32x4 pack8(const f32x4 a, const f32x4 b) { u32x4 w; w.x = cvt_pk_bf16(a[0], a[1]); w.y = cvt_pk_bf16(a[2], a[3]); w.z = cvt_pk_bf16(b[0], b[1]); w.w = cvt_pk_bf16(b[2], b[3]); return w; }
__device__ __forceinline__ float sigmoid_f(float v) { return __builtin_amdgcn_rcpf(1.0f + __builtin_amdgcn_exp2f(-1.4426950408889634f * v)); }

struct EpiStore {
    static constexpr bool PERM = true, AFTER_DRAIN = false;
    bf16_t* O; int ldc;
    __device__ __forceinline__ void operator()(const f32x4 (&acc)[2][2][4][2], const Unit& u, int wr, int wc, int fr, int fq) const {
        const int row0 = u.pm * BM + wr * 64 + fr, col0 = u.pn * BM + wc * 32 + 8 * fq;
#pragma unroll
        for (int ai = 0; ai < 2; ++ai)
#pragma unroll
            for (int m = 0; m < 4; ++m) { bf16_t* rowp = O + (size_t)(row0 + ai * HALF + m * 16) * ldc + col0;
#pragma unroll
                for (int bj = 0; bj < 2; ++bj) *(u32x4*)(rowp + bj * HALF) = pack8(acc[ai][bj][m][0], acc[ai][bj][m][1]); }
    }
};
struct EpiSwiGLU {
    static constexpr bool PERM = true, AFTER_DRAIN = false;
    bf16_t* O; int ldc;
    __device__ __forceinline__ void operator()(const f32x4 (&acc)[2][2][4][2], const Unit& u, int wr, int wc, int fr, int fq) const {
        const int row0 = u.pm * BM + wr * 64 + fr, col0 = u.pn * HALF + wc * 32 + 8 * fq;
#pragma unroll
        for (int ai = 0; ai < 2; ++ai)
#pragma unroll
            for (int m = 0; m < 4; ++m) { f32x4 h[2];
#pragma unroll
                for (int n = 0; n < 2; ++n) { const f32x4 g = acc[ai][0][m][n], v = acc[ai][1][m][n];
#pragma unroll
                    for (int e = 0; e < 4; ++e) h[n][e] = g[e] * sigmoid_f(g[e]) * v[e]; }
                *(u32x4*)(O + (size_t)(row0 + ai * HALF + m * 16) * ldc + col0) = pack8(h[0], h[1]); }
    }
};
struct EpiProj {
    static constexpr bool PERM = true, AFTER_DRAIN = false;
    bf16_t *QA, *KA, *VA, *QB, *KB, *VB, *GA, *GB; const float* cosT; const float* sinT; const float* gbias;
    __device__ __forceinline__ void operator()(const f32x4 (&acc)[2][2][4][2], const Unit& u, int wr, int wc, int fr, int fq) const {
        const int pn = u.pn, row0 = u.pm * BM + wr * 64 + fr;
        const bool rope = (pn <= 4) || (pn >= 6 && pn <= 13);
        if (rope) {
            const int i0 = (wc & 1) * 32 + 8 * fq, hl = wc >> 1;
            bf16_t* hb; int nh, hd;
            if (pn <= 3) { hb = QA; nh = 8; hd = 2 * pn + hl; } else if (pn == 4) { hb = KA; nh = 2; hd = hl; } else if (pn <= 9) { hb = QB; nh = 8; hd = 2 * (pn - 6) + hl; } else { hb = KB; nh = 8; hd = 2 * (pn - 10) + hl; }
#pragma unroll
            for (int ai = 0; ai < 2; ++ai)
#pragma unroll
                for (int m = 0; m < 4; ++m) { const int row = row0 + ai * HALF + m * 16, pos = row & 16383, b = row >> 14;
                    const f32x4* cp = (const f32x4*)(cosT + (size_t)pos * 64 + i0); const f32x4* sp = (const f32x4*)(sinT + (size_t)pos * 64 + i0);
                    f32x4 y1[2], y2[2];
#pragma unroll
                    for (int n = 0; n < 2; ++n) { const f32x4 c = cp[n], s = sp[n], x1 = acc[ai][0][m][n], x2 = acc[ai][1][m][n]; y1[n] = x1 * c - x2 * s; y2[n] = x2 * c + x1 * s; }
                    bf16_t* rowp = hb + ((size_t)(b * nh + hd) * 16384 + pos) * 128 + i0;
                    *(u32x4*)(rowp) = pack8(y1[0], y1[1]); *(u32x4*)(rowp + 64) = pack8(y2[0], y2[1]); }
        } else if (pn < 18) {
            const int dcol = wc * 32 + 8 * fq;
#pragma unroll
            for (int ai = 0; ai < 2; ++ai)
#pragma unroll
                for (int m = 0; m < 4; ++m) { const int row = row0 + ai * HALF + m * 16, pos = row & 16383, b = row >> 14;
#pragma unroll
                    for (int bj = 0; bj < 2; ++bj) {
                        bf16_t* dst = (pn == 5) ? VA + ((size_t)(b * 2 + bj) * 16384 + pos) * 128 + dcol
                                                : VB + ((size_t)(b * 4 + (pn - 14)) * 16384 + pos) * 256 + bj * HALF + dcol;
                        *(u32x4*)dst = pack8(acc[ai][bj][m][0], acc[ai][bj][m][1]); } }
        } else {
            const int col0 = pn * BM + wc * 32 + 8 * fq;
            bf16_t* gbuf = (pn < 26) ? GA : GB; const int gcol0 = (pn < 26 ? (pn - 18) : (pn - 26)) * BM + wc * 32 + 8 * fq;
            f32x4 bv[2][2];
#pragma unroll
            for (int bj = 0; bj < 2; ++bj)
#pragma unroll
                for (int n = 0; n < 2; ++n) bv[bj][n] = *(const f32x4*)(gbias + (col0 - 4608) + bj * HALF + 4 * n);
#pragma unroll
            for (int ai = 0; ai < 2; ++ai)
#pragma unroll
                for (int m = 0; m < 4; ++m) { bf16_t* rowp = gbuf + (size_t)(row0 + ai * HALF + m * 16) * 2048 + gcol0;
#pragma unroll
                    for (int bj = 0; bj < 2; ++bj) { f32x4 v[2];
#pragma unroll
                        for (int n = 0; n < 2; ++n) { const f32x4 t = acc[ai][bj][m][n] + bv[bj][n];
#pragma unroll
                            for (int e = 0; e < 4; ++e) v[n][e] = sigmoid_f(t[e]); }
                        *(u32x4*)(rowp + bj * HALF) = pack8(v[0], v[1]); } }
        }
    }
};
template <int PASS> struct EpiGate {
    static constexpr bool PERM = true, AFTER_DRAIN = false;
    bf16_t* T; const bf16_t* gate;
    __device__ __forceinline__ void operator()(const f32x4 (&acc)[2][2][4][2], const Unit& u, int wr, int wc, int fr, int fq) const {
        const int row0 = u.pm * BM + wr * 64 + fr, col0 = u.pn * BM + wc * 32 + 8 * fq;
#pragma unroll
        for (int ai = 0; ai < 2; ++ai) {
            u32x4 gw[4][2], tw[4][2];
#pragma unroll
            for (int m = 0; m < 4; ++m)
#pragma unroll
                for (int bj = 0; bj < 2; ++bj) { const int row = row0 + ai * HALF + m * 16, col = col0 + bj * HALF;
                    gw[m][bj] = *(const u32x4*)(gate + (size_t)row * 2048 + col);
                    if (PASS == 1) tw[m][bj] = *(const u32x4*)(T + (size_t)row * 2048 + col); }
#pragma unroll
            for (int m = 0; m < 4; ++m)
#pragma unroll
                for (int bj = 0; bj < 2; ++bj) { const int row = row0 + ai * HALF + m * 16, col = col0 + bj * HALF;
                    const u32x4 g = gw[m][bj];
                    const f32x4 g0 = {bf_lo(g.x), bf_hi(g.x), bf_lo(g.y), bf_hi(g.y)}, g1 = {bf_lo(g.z), bf_hi(g.z), bf_lo(g.w), bf_hi(g.w)};
                    f32x4 v0 = g0 * acc[ai][bj][m][0], v1 = g1 * acc[ai][bj][m][1];
                    if (PASS == 1) { const u32x4 t = tw[m][bj];
                        v0 += (f32x4){bf_lo(t.x), bf_hi(t.x), bf_lo(t.y), bf_hi(t.y)}; v1 += (f32x4){bf_lo(t.z), bf_hi(t.z), bf_lo(t.w), bf_hi(t.w)}; }
                    *(u32x4*)(T + (size_t)row * 2048 + col) = pack8(v0, v1); }
        }
    }
};

template <class Epi, class Sched, bool ALIGN_EPI = false, bool SP2 = false>
__device__ __forceinline__ void gemm_phase(PG8_LAS unsigned char* lds, const Gemm g, const Sched& S, const Epi& E) {
    const int tid = threadIdx.x, wid = __builtin_amdgcn_readfirstlane(tid >> 6), lane = tid & 63, wr = wid >> 2, wc = wid & 3, fr = lane & 15, fq = lane >> 4;
    const int K = g.K, nt = K / BK;
    unsigned voffA[2], voffB[2];
#pragma unroll
    for (int i = 0; i < 2; ++i) { int R, C; stage_rc(tid * 16 + i * 8192, R, C); const int Rb = Epi::PERM ? ((R & ~31) + perm32(R & 31)) : R;
        voffA[i] = (unsigned)(R * K + C) * 2u; voffB[i] = (unsigned)(Rb * K + C) * 2u; }
    const size_t kstep = (size_t)(BK * 2);
    const size_t hstep = (size_t)HALF * K * 2;
    const size_t tstep = 2 * hstep;
    const unsigned ldsw = (unsigned)wid * 1024u;
    const int aoff = lds_byte(wr * 64 + fr, fq * 8), boff = lds_byte(wc * 32 + fr, fq * 8);
#define PG8_SA(b, h) (((b) * 2 + (h)) * HTB)
#define PG8_SB(b, h) ((4 + (b) * 2 + (h)) * HTB)
#define PG8_STAGE(bufoff, gbase, voff) do { _Pragma("unroll") for (int _i = 0; _i < 2; ++_i) \
        __builtin_amdgcn_global_load_lds((const unsigned*)((const char*)(gbase) + (voff)[_i]), (PG8_LAS unsigned*)(lds + (bufoff) + ldsw + _i * 8192), 16, 0, 0); } while (0)
#define PG8_LDA(dst, b, h) do { _Pragma("unroll") for (int m = 0; m < 4; ++m) _Pragma("unroll") for (int k = 0; k < 2; ++k) dst[m][k] = *(const PG8_LAS bf16x8*)(lds + PG8_SA(b, h) + aoff + m * 2048 + k * 1024); } while (0)
#define PG8_LDB(dst, b, h) do { _Pragma("unroll") for (int n = 0; n < 2; ++n) _Pragma("unroll") for (int k = 0; k < 2; ++k) dst[n][k] = *(const PG8_LAS bf16x8*)(lds + PG8_SB(b, h) + boff + n * 2048 + k * 1024); } while (0)
#define PG8_MMA(ai, bj, At, Bt) do { __builtin_amdgcn_s_setprio(1); _Pragma("unroll") for (int m = 0; m < 4; ++m) _Pragma("unroll") for (int n = 0; n < 2; ++n) _Pragma("unroll") for (int k = 0; k < 2; ++k) \
        acc[ai][bj][m][n] = __builtin_amdgcn_mfma_f32_16x16x32_bf16(Bt[n][k], At[m][k], acc[ai][bj][m][n], 0, 0, 0); __builtin_amdgcn_s_setprio(0); } while (0)
#define PG8_WAIT_V(n) asm volatile("s_waitcnt vmcnt(" #n ")" ::: "memory")
#define PG8_WAIT_L(n) asm volatile("s_waitcnt lgkmcnt(" #n ")" ::: "memory")
#define PG8_BAR __builtin_amdgcn_s_barrier()
#define PG8_SCHED __builtin_amdgcn_sched_barrier(0)
    Unit cur, nxt; int ui = 0;
    if (!S.next(0, cur)) return;
    f32x4 acc[2][2][4][2];
#pragma unroll
    for (int a = 0; a < 2; ++a)
#pragma unroll
        for (int b = 0; b < 2; ++b)
#pragma unroll
            for (int m = 0; m < 4; ++m)
#pragma unroll
                for (int n = 0; n < 2; ++n) acc[a][b][m][n] = (f32x4){0.f, 0.f, 0.f, 0.f};
    bf16x8 At[4][2], B0[2][2], B1[2][2];
    const char* cA = (const char*)g.A + (size_t)cur.pm * tstep; const char* cB = (const char*)g.Bt + (size_t)cur.pn * tstep;
    S.a_ready(cur);
    if constexpr (SP2) {
        PG8_STAGE(PG8_SB(0, 0), cB, voffB); PG8_STAGE(PG8_SB(0, 1), cB + hstep, voffB); PG8_STAGE(PG8_SA(0, 0), cA, voffA); PG8_STAGE(PG8_SA(0, 1), cA + hstep, voffA);
        if (wr == 1) PG8_BAR;
        PG8_WAIT_V(2); PG8_BAR;
        PG8_STAGE(PG8_SB(1, 0), cB + kstep, voffB); PG8_STAGE(PG8_SA(1, 0), cA + kstep, voffA); PG8_STAGE(PG8_SB(1, 1), cB + hstep + kstep, voffB);
        PG8_WAIT_V(6); PG8_BAR;
    } else {
        PG8_STAGE(PG8_SB(0, 0), cB, voffB); PG8_STAGE(PG8_SA(0, 0), cA, voffA); PG8_STAGE(PG8_SB(0, 1), cB + hstep, voffB); PG8_STAGE(PG8_SA(0, 1), cA + hstep, voffA);
        if (wr == 1) PG8_BAR;
        PG8_WAIT_V(4); PG8_BAR;
        PG8_STAGE(PG8_SB(1, 0), cB + kstep, voffB); PG8_STAGE(PG8_SA(1, 0), cA + kstep, voffA); PG8_STAGE(PG8_SB(1, 1), cB + hstep + kstep, voffB);
        PG8_WAIT_V(6); PG8_BAR;
    }
    for (;;) {
        const bool has_next = S.next(ui + 1, nxt);
        const char* nA = has_next ? (const char*)g.A + (size_t)nxt.pm * tstep : cA; const char* nB = has_next ? (const char*)g.Bt + (size_t)nxt.pn * tstep : cB;
        for (int t = 0; t < nt; t += 2) {
            const bool last = (t == nt - 2);
            const char* a1 = cA + (size_t)(t + 1) * kstep;
            const char* a2 = last ? nA : cA + (size_t)(t + 2) * kstep; const char* b2 = last ? nB : cB + (size_t)(t + 2) * kstep;
            const char* a3 = a2 + kstep; const char* b3 = b2 + kstep;
            if (last && has_next) S.a_ready(nxt);
            if constexpr (SP2) {
            PG8_LDB(B0, 0, 0); PG8_LDB(B1, 0, 1); PG8_SCHED; PG8_LDA(At, 0, 0); PG8_STAGE(PG8_SA(1, 1), a1 + hstep, voffA);
            PG8_WAIT_V(8); PG8_WAIT_L(0); PG8_BAR; PG8_MMA(0, 0, At, B0); PG8_MMA(0, 1, At, B1); PG8_BAR; PG8_SCHED;
            PG8_LDA(At, 0, 1); PG8_STAGE(PG8_SB(0, 0), b2, voffB); PG8_STAGE(PG8_SB(0, 1), b2 + hstep, voffB); PG8_STAGE(PG8_SA(0, 0), a2, voffA);
            PG8_WAIT_V(8); PG8_WAIT_L(0); PG8_BAR; PG8_MMA(1, 0, At, B0); PG8_MMA(1, 1, At, B1); PG8_BAR; PG8_SCHED;
            PG8_LDB(B0, 1, 0); PG8_LDB(B1, 1, 1); PG8_SCHED; PG8_LDA(At, 1, 0); PG8_STAGE(PG8_SA(0, 1), a2 + hstep, voffA);
            PG8_WAIT_V(8); PG8_WAIT_L(0); PG8_BAR; PG8_MMA(0, 0, At, B0); PG8_MMA(0, 1, At, B1); PG8_BAR; PG8_SCHED;
            PG8_LDA(At, 1, 1); PG8_STAGE(PG8_SB(1, 0), b3, voffB); PG8_STAGE(PG8_SB(1, 1), b3 + hstep, voffB); PG8_STAGE(PG8_SA(1, 0), a3, voffA);
            PG8_WAIT_V(8); PG8_WAIT_L(0); PG8_BAR; PG8_MMA(1, 0, At, B0); PG8_MMA(1, 1, At, B1); PG8_BAR; PG8_SCHED;
            } else {
            PG8_LDB(B0, 0, 0); PG8_SCHED; PG8_LDA(At, 0, 0); PG8_STAGE(PG8_SA(1, 1), a1 + hstep, voffA);
            PG8_WAIT_L(8); PG8_BAR; PG8_WAIT_L(0); PG8_MMA(0, 0, At, B0); PG8_BAR; PG8_SCHED;
            PG8_LDB(B1, 0, 1); PG8_STAGE(PG8_SB(0, 0), b2, voffB);
            PG8_BAR; PG8_WAIT_L(0); PG8_MMA(0, 1, At, B1); PG8_BAR;
            PG8_LDA(At, 0, 1); PG8_STAGE(PG8_SA(0, 0), a2, voffA);
            PG8_BAR; PG8_WAIT_L(0); PG8_MMA(1, 0, At, B0); PG8_BAR; PG8_SCHED;
            PG8_STAGE(PG8_SB(0, 1), b2 + hstep, voffB);
            PG8_WAIT_V(6); PG8_BAR; PG8_MMA(1, 1, At, B1); PG8_BAR;
            PG8_LDB(B0, 1, 0); PG8_SCHED; PG8_LDA(At, 1, 0); PG8_STAGE(PG8_SA(0, 1), a2 + hstep, voffA);
            PG8_WAIT_L(8); PG8_BAR; PG8_WAIT_L(0); PG8_MMA(0, 0, At, B0); PG8_BAR; PG8_SCHED;
            PG8_LDB(B1, 1, 1); PG8_STAGE(PG8_SB(1, 0), b3, voffB);
            PG8_BAR; PG8_WAIT_L(0); PG8_MMA(0, 1, At, B1); PG8_BAR;
            PG8_LDA(At, 1, 1); PG8_STAGE(PG8_SA(1, 0), a3, voffA);
            PG8_BAR; PG8_WAIT_L(0); PG8_MMA(1, 0, At, B0); PG8_BAR; PG8_SCHED;
            PG8_STAGE(PG8_SB(1, 1), b3 + hstep, voffB);
            PG8_WAIT_V(6); PG8_BAR; PG8_MMA(1, 1, At, B1); PG8_BAR;
            }
        }
        if constexpr (ALIGN_EPI) { if (wr == 0) PG8_BAR; }
        if constexpr (!Epi::AFTER_DRAIN) { E(acc, cur, wr, wc, fr, fq); S.done(cur); }
        if (!has_next) break;
#pragma unroll
        for (int a = 0; a < 2; ++a)
#pragma unroll
            for (int b = 0; b < 2; ++b)
#pragma unroll
                for (int m = 0; m < 4; ++m)
#pragma unroll
                    for (int n = 0; n < 2; ++n) acc[a][b][m][n] = (f32x4){0.f, 0.f, 0.f, 0.f};
        cur = nxt; cA = nA; cB = nB; ++ui;
        if constexpr (ALIGN_EPI) { if (wr == 1) PG8_BAR; }
    }
    PG8_WAIT_V(0);
    if constexpr (!ALIGN_EPI) { if (wr == 0) PG8_BAR; }
    PG8_BAR;
    if constexpr (Epi::AFTER_DRAIN) { E.fused(acc, cur, wr, wc, fr, fq, lds, wid, lane); S.done(cur); }
#undef PG8_SA
#undef PG8_SB
#undef PG8_STAGE
#undef PG8_LDA
#undef PG8_LDB
#undef PG8_MMA
#undef PG8_WAIT_V
#undef PG8_WAIT_L
#undef PG8_BAR
#undef PG8_SCHED
}
}
namespace att {
typedef unsigned short bf16_t;
constexpr int   D = 128, NW = 8, QBLK = 32, KVBLK = 64;
constexpr float SCALE = 0.088388347648318440f;
constexpr float THR = 8.f;
constexpr int   LDQ = 128, LDK = 128, LDV2 = 256;
constexpr size_t SHM_V = KVBLK * D * 2, SHM_K = KVBLK * D * 2, SHM_ATTN = 2 * SHM_V + 2 * SHM_K + NW * 64 * 4;
using bf16x8 = __attribute__((ext_vector_type(8))) short;
using s16x4  = __attribute__((ext_vector_type(4))) short;
using f32x16 = __attribute__((ext_vector_type(16))) float;
using u32x4  = __attribute__((ext_vector_type(4))) unsigned;
#define KSWZ(row, colB) ((row) * 256 + ((colB) ^ (((row) & 7) << 4)))
#define SBAR() __builtin_amdgcn_sched_barrier(0)
__device__ __forceinline__ int crow(int r, int hi) { return (r & 3) + 8 * (r >> 2) + 4 * hi; }
typedef float f32x2a __attribute__((ext_vector_type(2))); typedef __bf16 bf16x2a __attribute__((ext_vector_type(2)));
__device__ __forceinline__ unsigned cvtpk(float lo, float hi) { f32x2a v = {lo, hi}; bf16x2a b = __builtin_convertvector(v, bf16x2a); return __builtin_bit_cast(unsigned, b); }
__device__ __forceinline__ bf16x8 ld8(const bf16_t* p) { return *reinterpret_cast<const bf16x8*>(p); }

template <bool WIN>
__device__ __forceinline__ void partialSM(f32x16& p0, f32x16& p1, float& m_reg, float& mn, float& alpha) {
  constexpr float C = SCALE * 1.4426950408889634f;
  float pmax = p0[0];
#pragma unroll
  for (int r = 1; r < 16; ++r) pmax = fmaxf(pmax, p0[r]);
#pragma unroll
  for (int r = 0; r < 16; ++r) pmax = fmaxf(pmax, p1[r]);
  { auto rr = __builtin_amdgcn_permlane32_swap(__float_as_uint(pmax), __float_as_uint(pmax), false, false);
    pmax = fmaxf(__uint_as_float(rr[0]), __uint_as_float(rr[1])); }
  if (__builtin_expect(__all(pmax - m_reg <= THR / SCALE), 1)) { mn = m_reg; alpha = 1.f; }
  else { mn = fmaxf(m_reg, pmax); alpha = __builtin_amdgcn_exp2f((m_reg - mn) * C); m_reg = mn; }
  float mnC = -mn * C;
#pragma unroll
  for (int r = 0; r < 16; ++r) p0[r] = fmaf(p0[r], C, mnC);
#pragma unroll
  for (int r = 0; r < 16; ++r) p1[r] = fmaf(p1[r], C, mnC);
#pragma unroll
  for (int r = 0; r < 16; ++r) p0[r] = __builtin_amdgcn_exp2f(p0[r]);
}
__device__ __forceinline__ void finishSM(f32x16& p0, f32x16& p1, float alpha, float& l_reg, bf16x8& pa0, bf16x8& pa1, bf16x8& pa2, bf16x8& pa3) {
#pragma unroll
  for (int r = 0; r < 16; ++r) p1[r] = __builtin_amdgcn_exp2f(p1[r]);
  float ps = 0;
#pragma unroll
  for (int r = 0; r < 16; ++r) ps += p0[r];
#pragma unroll
  for (int r = 0; r < 16; ++r) ps += p1[r];
  { auto rr = __builtin_amdgcn_permlane32_swap(__float_as_uint(ps), __float_as_uint(ps), false, false);
    ps = __uint_as_float(rr[0]) + __uint_as_float(rr[1]); }
  l_reg = l_reg * alpha + ps;
#define PK4(P, BASE, OUT) do { unsigned a0 = cvtpk(P[BASE + 0], P[BASE + 1]), a1 = cvtpk(P[BASE + 2], P[BASE + 3]);   \
    unsigned b0 = cvtpk(P[BASE + 4], P[BASE + 5]), b1 = cvtpk(P[BASE + 6], P[BASE + 7]);                              \
    auto r0 = __builtin_amdgcn_permlane32_swap(a0, b0, false, false); auto r1 = __builtin_amdgcn_permlane32_swap(a1, b1, false, false); \
    u32x4 w = {r0[0], r1[0], r0[1], r1[1]}; OUT = *reinterpret_cast<bf16x8*>(&w); } while (0)
  PK4(p0, 0, pa0); PK4(p0, 8, pa1); PK4(p1, 0, pa2); PK4(p1, 8, pa3);
#undef PK4
}
template <bool WIN>
__device__ __forceinline__ void qkt(f32x16& p0, f32x16& p1, const bf16_t* Ks, const bf16x8* qr, int r32, int hi, int dq) {
  p0 = f32x16{}; p1 = f32x16{};
  if (WIN) {
    const int t = 4 * hi - dq + 128;
#pragma unroll
    for (int r = 0; r < 16; ++r) { const unsigned d0 = (unsigned)(t + (r & 3) + 8 * (r >> 2)), d1 = d0 + 32u;
      p0[r] = d0 > 256u ? -1e30f : 0.f; p1[r] = d1 > 256u ? -1e30f : 0.f; }
  }
#pragma unroll
  for (int d0 = 0; d0 < 8; ++d0) { int cb = (d0 * 16 + hi * 8) * 2;
    bf16x8 b0 = *reinterpret_cast<const bf16x8*>((const char*)Ks + KSWZ(r32, cb));
    bf16x8 b1 = *reinterpret_cast<const bf16x8*>((const char*)Ks + KSWZ(32 + r32, cb));
    p0 = __builtin_amdgcn_mfma_f32_32x32x16_bf16(b0, qr[d0], p0, 0, 0, 0);
    p1 = __builtin_amdgcn_mfma_f32_32x32x16_bf16(b1, qr[d0], p1, 0, 0, 0); }
}
__device__ __forceinline__ int v_st(int k, int c) { const int kk = (k & ~0xC) | ((k & 4) << 1) | ((k & 8) >> 1); return ((kk >> 3) * 4 + (c >> 5)) * 512 + ((kk & 7) * 32 + (c & 31)) * 2; }
__device__ __forceinline__ int v_rd_base(int lane) { return ((lane & 3) << 3) | (((lane >> 2) & 3) << 6) | (((lane >> 4) & 1) << 5) | (((lane >> 5) & 1) << 8); }
constexpr int v_rd_off(int d0, int ks, int half) { return d0 * 512 + ks * 4096 + half * 2048; }
template <int OFF> __device__ __forceinline__ s16x4 tr_read(int vb) {
  s16x4 r; asm volatile("ds_read_b64_tr_b16 %0, %1 offset:%2" : "=&v"(r) : "v"(vb), "i"(OFF) : "memory"); return r;
}
template <int D0> __device__ __forceinline__ void pv_one(f32x16& od, int vb, bf16x8 pa0, bf16x8 pa1, bf16x8 pa2, bf16x8 pa3) {
  const s16x4 l0 = tr_read<v_rd_off(D0, 0, 0)>(vb), h0 = tr_read<v_rd_off(D0, 0, 1)>(vb), l1 = tr_read<v_rd_off(D0, 1, 0)>(vb), h1 = tr_read<v_rd_off(D0, 1, 1)>(vb);
  const s16x4 l2 = tr_read<v_rd_off(D0, 2, 0)>(vb), h2 = tr_read<v_rd_off(D0, 2, 1)>(vb), l3 = tr_read<v_rd_off(D0, 3, 0)>(vb), h3 = tr_read<v_rd_off(D0, 3, 1)>(vb);
  asm volatile("s_waitcnt lgkmcnt(0)" ::: "memory"); SBAR();
#define PK(L, H) (bf16x8){L[0], L[1], L[2], L[3], H[0], H[1], H[2], H[3]}
  od = __builtin_amdgcn_mfma_f32_32x32x16_bf16(pa0, PK(l0, h0), od, 0, 0, 0);
  od = __builtin_amdgcn_mfma_f32_32x32x16_bf16(pa1, PK(l1, h1), od, 0, 0, 0);
  od = __builtin_amdgcn_mfma_f32_32x32x16_bf16(pa2, PK(l2, h2), od, 0, 0, 0);
  od = __builtin_amdgcn_mfma_f32_32x32x16_bf16(pa3, PK(l3, h3), od, 0, 0, 0);
#undef PK
}
__device__ __forceinline__ void pv_d0(f32x16* o, int vb, bf16x8 pa0, bf16x8 pa1, bf16x8 pa2, bf16x8 pa3) {
  pv_one<0>(o[0], vb, pa0, pa1, pa2, pa3); pv_one<1>(o[1], vb, pa0, pa1, pa2, pa3); pv_one<2>(o[2], vb, pa0, pa1, pa2, pa3); pv_one<3>(o[3], vb, pa0, pa1, pa2, pa3);
}

template <bool WIN, int LDO>
__device__ __forceinline__ void attn_unit(const bf16_t* __restrict__ Qb, const bf16_t* __restrict__ Kh, const bf16_t* __restrict__ Vh,
                                          bf16_t* __restrict__ Ob, int NT, int dq_base, float m_init, float l_init, char* lds) {
  const int tid = threadIdx.x, wid = tid >> 6, lane = tid & 63, r32 = lane & 31, hi = lane >> 5;
  bf16_t* V_lds = (bf16_t*)lds; bf16_t* K_lds = (bf16_t*)(lds + 2 * SHM_V);
  float* ws = (float*)(lds + 2 * SHM_V + 2 * SHM_K) + wid * 64; float* li_l = ws; float* al_l = ws + 32;
  float m_reg = m_init, l_reg = l_init; f32x16 o[4] = {}; bf16x8 qr[8];
  const int dq0 = dq_base + wid * QBLK + r32;
  const bf16_t* Qw = Qb + (long)(wid * QBLK + r32) * LDQ + hi * 8;
#pragma unroll
  for (int d0 = 0; d0 < 8; ++d0) qr[d0] = ld8(Qw + d0 * 16);
  const int sr = tid >> 4, sc = (tid & 15) * 8, vst0 = v_st(sr, sc), vst1 = v_st(32 + sr, sc);
  const int vb0 = (int)(uintptr_t)V_lds + v_rd_base(lane);
  bf16x8 vsA0, vsA1, ksA0, ksA1, vsB0, vsB1, ksB0, ksB1;
  const unsigned goff = (unsigned)(sr * LDK + sc) * 2u;
#define GLD(base, k0, extra) (*reinterpret_cast<const bf16x8*>((const char*)(base) + (size_t)(k0) * (LDK * 2) + (extra) + goff))
#define SLOAD_A(k0) do { vsA0 = GLD(Vh, k0, 0); vsA1 = GLD(Vh, k0, 32 * LDK * 2); ksA0 = GLD(Kh, k0, 0); ksA1 = GLD(Kh, k0, 32 * LDK * 2); } while (0)
#define SLOAD_B(k0) do { vsB0 = GLD(Vh, k0, 0); vsB1 = GLD(Vh, k0, 32 * LDK * 2); ksB0 = GLD(Kh, k0, 0); ksB1 = GLD(Kh, k0, 32 * LDK * 2); } while (0)
#define SWRITE_A() do { *(bf16x8*)((char*)V_lds + vst0) = vsA0; *(bf16x8*)((char*)V_lds + vst1) = vsA1; const int kc = sc * 2; \
    *(bf16x8*)((char*)K_lds + KSWZ(sr, kc)) = ksA0; *(bf16x8*)((char*)K_lds + KSWZ(32 + sr, kc)) = ksA1; } while (0)
#define SWRITE_B() do { *(bf16x8*)((char*)V_lds + SHM_V + vst0) = vsB0; *(bf16x8*)((char*)V_lds + SHM_V + vst1) = vsB1; const int kc = sc * 2; \
    *(bf16x8*)((char*)K_lds + SHM_K + KSWZ(sr, kc)) = ksB0; *(bf16x8*)((char*)K_lds + SHM_K + KSWZ(32 + sr, kc)) = ksB1; } while (0)
#define SWAIT() asm volatile("s_waitcnt vmcnt(4)" ::: "memory")
#define RESC(a) do { if (__any((a) < 1.f)) { if (hi == 0) al_l[r32] = (a); asm volatile("s_waitcnt lgkmcnt(0)" ::: "memory"); \
    _Pragma("unroll") for (int d = 0; d < 4; ++d) _Pragma("unroll") for (int r = 0; r < 16; ++r) o[d][r] *= al_l[crow(r, hi)]; } } while (0)
  f32x16 pA0, pA1, pB0, pB1; float mnA, mnB, alA, alB; bf16x8 pa0, pa1, pa2, pa3;
  SLOAD_A(0); asm volatile("s_waitcnt vmcnt(0)" ::: "memory"); SWRITE_A(); __syncthreads();
  qkt<WIN>(pA0, pA1, K_lds, qr, r32, hi, dq0); partialSM<WIN>(pA0, pA1, m_reg, mnA, alA);
  SLOAD_B(KVBLK); if (2 < NT) SLOAD_A(2 * KVBLK);
  SWAIT(); SWRITE_B(); __syncthreads();
  for (int j = 1; j + 1 < NT; j += 2) {
    SBAR(); qkt<WIN>(pB0, pB1, (bf16_t*)((char*)K_lds + SHM_K), qr, r32, hi, dq0 - j * KVBLK);
    finishSM(pA0, pA1, alA, l_reg, pa0, pa1, pa2, pa3); SBAR();
    SLOAD_B((j + 2) * KVBLK); SBAR();
    pv_d0(o, vb0, pa0, pa1, pa2, pa3); partialSM<WIN>(pB0, pB1, m_reg, mnB, alB);
    __syncthreads(); SWAIT(); SWRITE_A();
    RESC(alB); __syncthreads();
    SBAR(); qkt<WIN>(pA0, pA1, K_lds, qr, r32, hi, dq0 - (j + 1) * KVBLK);
    finishSM(pB0, pB1, alB, l_reg, pa0, pa1, pa2, pa3); SBAR();
    if (j + 3 < NT) SLOAD_A((j + 3) * KVBLK); SBAR();
    pv_d0(o, vb0 + (int)SHM_V, pa0, pa1, pa2, pa3); partialSM<WIN>(pA0, pA1, m_reg, mnA, alA);
    __syncthreads(); SWAIT(); SWRITE_B();
    RESC(alA); __syncthreads();
  }
  SBAR(); qkt<WIN>(pB0, pB1, (bf16_t*)((char*)K_lds + SHM_K), qr, r32, hi, dq0 - (NT - 1) * KVBLK);
  finishSM(pA0, pA1, alA, l_reg, pa0, pa1, pa2, pa3); SBAR();
  pv_d0(o, vb0, pa0, pa1, pa2, pa3); partialSM<WIN>(pB0, pB1, m_reg, mnB, alB);
  __syncthreads(); RESC(alB);
  finishSM(pB0, pB1, alB, l_reg, pa0, pa1, pa2, pa3); SBAR();
  pv_d0(o, vb0 + (int)SHM_V, pa0, pa1, pa2, pa3);
  if (hi == 0) li_l[r32] = l_reg; asm volatile("s_waitcnt lgkmcnt(0)" ::: "memory");
  float rli[16];
#pragma unroll
  for (int r = 0; r < 16; ++r) rli[r] = __builtin_amdgcn_rcpf(li_l[crow(r, hi)]);
  bf16_t* Ow = Ob + (long)(wid * QBLK) * LDO;
#pragma unroll
  for (int r = 0; r < 16; ++r) { const int orow = crow(r, hi);
#pragma unroll
    for (int d0 = 0; d0 < 4; ++d0) Ow[(long)orow * LDO + d0 * 32 + r32] = (bf16_t)(cvtpk(o[d0][r] * rli[r], 0.f) & 0xffffu); }
  __syncthreads();
#undef SLOAD_A
#undef GLD
#undef SLOAD_B
#undef SWRITE_A
#undef SWRITE_B
#undef SWAIT
#undef RESC
}

#define LAS3 __attribute__((address_space(3)))
constexpr int DV_K0 = 0, DV_V0 = 32768, DV_WS = 98304, DV_LDS = DV_WS + NW * 256;
__device__ __forceinline__ void dma16(const void* g, LAS3 unsigned char* l) { __builtin_amdgcn_global_load_lds((const unsigned*)g, (LAS3 unsigned*)l, 16, 0, 0); }
template <int LDO>
__device__ __forceinline__ void attn_unit_dv(const bf16_t* __restrict__ Qb, const bf16_t* __restrict__ Kh, const bf16_t* __restrict__ Vh, bf16_t* __restrict__ Ob, int NT, char* lds, LAS3 unsigned char* ldsl) {
  const int tid = threadIdx.x, lane = tid & 63, r32 = lane & 31, hi = lane >> 5; const int wid = __builtin_amdgcn_readfirstlane(tid >> 6);
  float* ws = (float*)(lds + DV_WS) + wid * 64; float* li_l = ws; float* al_l = ws + 32;
  float m_reg = -1e30f, l_reg = 0.f; f32x16 o[8] = {}; bf16x8 qr[8];
  const unsigned koff0 = (unsigned)((8 * wid + (lane >> 4)) * (LDK * 2) + (((lane & 15) ^ (lane >> 4)) << 4));
  const int hf = wid >> 2;
  unsigned voff0;
  { const int lc = (4 * wid) & 15, b = lc * 1024 + 16 * lane, sub = b >> 9, e = (b & 511) >> 1;
    const int kk = (sub >> 2) * 8 + (e >> 5), c = (sub & 3) * 32 + (e & 31), k = (kk & ~0xC) | ((kk & 4) << 1) | ((kk & 8) >> 1);
    voff0 = (unsigned)(k * (LDV2 * 2) + (hf * 128 + c) * 2); }
  LAS3 unsigned char* kdst = ldsl + DV_K0 + wid * 2048;
  LAS3 unsigned char* vdst = ldsl + DV_V0 + hf * 16384 + ((4 * wid) & 15) * 1024;
#define DMA_KV(t, buf) do { const char* kb_ = (const char*)Kh + (size_t)(t) * (64 * LDK * 2); const char* vb_ = (const char*)Vh + (size_t)(t) * (64 * LDV2 * 2); \
    dma16(kb_ + koff0, kdst + (buf) * 16384); dma16(kb_ + 4 * (LDK * 2) + (koff0 ^ 64u), kdst + (buf) * 16384 + 1024); \
    dma16(vb_ + voff0, vdst + (buf) * 32768); dma16(vb_ + 128 + voff0, vdst + (buf) * 32768 + 1024); \
    dma16(vb_ + 4 * (LDV2 * 2) + voff0, vdst + (buf) * 32768 + 2048); dma16(vb_ + 4 * (LDV2 * 2) + 128 + voff0, vdst + (buf) * 32768 + 3072); } while (0)
#define RESC8(a) do { if (__any((a) < 1.f)) { if (hi == 0) al_l[r32] = (a); asm volatile("s_waitcnt lgkmcnt(0)" ::: "memory"); \
    _Pragma("unroll") for (int d = 0; d < 8; ++d) _Pragma("unroll") for (int r = 0; r < 16; ++r) o[d][r] *= al_l[crow(r, hi)]; } } while (0)
  if (wid >= 4) __builtin_amdgcn_s_setprio(1);
  DMA_KV(0, 0);
  const bf16_t* Qw = Qb + (long)(wid * QBLK + r32) * LDQ + hi * 8;
#pragma unroll
  for (int d0 = 0; d0 < 8; ++d0) qr[d0] = ld8(Qw + d0 * 16);
  const int vb0 = (int)(uintptr_t)(lds + DV_V0) + v_rd_base(lane);
  asm volatile("s_waitcnt vmcnt(0) lgkmcnt(0)" ::: "memory"); __builtin_amdgcn_s_barrier(); asm volatile("" ::: "memory");
  for (int t = 0; t < NT; ++t) {
    const int buf = t & 1;
    f32x16 p0, p1; float mn, alpha; bf16x8 pa0, pa1, pa2, pa3;
    qkt<false>(p0, p1, (const bf16_t*)(lds + DV_K0 + buf * 16384), qr, r32, hi, 0);
    SBAR();
    if (t + 1 < NT) DMA_KV(t + 1, buf ^ 1);
    SBAR();
    partialSM<false>(p0, p1, m_reg, mn, alpha);
    finishSM(p0, p1, alpha, l_reg, pa0, pa1, pa2, pa3);
    RESC8(alpha);
    SBAR();
    pv_d0(o, vb0 + buf * 32768, pa0, pa1, pa2, pa3);
    pv_d0(o + 4, vb0 + buf * 32768 + 16384, pa0, pa1, pa2, pa3);
    asm volatile("s_waitcnt vmcnt(0) lgkmcnt(0)" ::: "memory"); __builtin_amdgcn_s_barrier(); asm volatile("" ::: "memory");
  }
  __builtin_amdgcn_s_setprio(0);
  if (hi == 0) li_l[r32] = l_reg; asm volatile("s_waitcnt lgkmcnt(0)" ::: "memory");
  float rli[16];
#pragma unroll
  for (int r = 0; r < 16; ++r) rli[r] = __builtin_amdgcn_rcpf(li_l[crow(r, hi)]);
  bf16_t* Ow = Ob + (long)(wid * QBLK) * LDO;
#pragma unroll
  for (int r = 0; r < 16; ++r) { const int orow = crow(r, hi);
#pragma unroll
    for (int d0 = 0; d0 < 8; ++d0) Ow[(long)orow * LDO + d0 * 32 + r32] = (bf16_t)(cvtpk(o[d0][r] * rli[r], 0.f) & 0xffffu); }
#undef DMA_KV
#undef RESC8
}
#undef KSWZ
#undef SBAR
}

#define GAS __attribute__((address_space(1)))
#define LAS __attribute__((address_space(3)))
typedef unsigned short bf16;
typedef unsigned v4u __attribute__((ext_vector_type(4)));
typedef float f32x4 __attribute__((ext_vector_type(4)));

constexpr int NWAVES = 8;
constexpr int M = 32768, DM = 2048, FF = 5632, SEQ = 16384, WIN_COLS = 8704;
constexpr float EPS = 1e-6f;
constexpr size_t MiB = 1u << 20;
constexpr size_t WS_W1GU = 0, WS_W1D = 44 * MiB, WS_W2GU = 66 * MiB, WS_W2D = 110 * MiB, WS_WIN = 132 * MiB, WS_WPA = 166 * MiB, WS_WPB = 170 * MiB, WS_WOUT = 174 * MiB;
constexpr size_t WS_COS = 182 * MiB, WS_SIN = 186 * MiB;
constexpr size_t WS_B = 190 * MiB;
constexpr size_t WS_C = 318 * MiB;
constexpr size_t WS_D = 446 * MiB;
constexpr size_t WS_CTL = 990 * MiB, CTL_BYTES = 65536;
constexpr size_t WS_END = 991 * MiB;
constexpr int LDS_BYTES = 134 * 1024;
constexpr int NPHASE = 14;
#ifndef MK_PER_PHASE
#define MK_PER_PHASE 0
#endif
#ifndef PH_LIMIT
#define PH_LIMIT NPHASE
#endif

__device__ __forceinline__ unsigned f2bf(float f) { unsigned u = __builtin_bit_cast(unsigned, f); return (u + 0x7fffu + ((u >> 16) & 1u)) >> 16; }
__device__ __forceinline__ unsigned pk2(float lo, float hi) { return pg8::cvt_pk_bf16(lo, hi); }
__device__ __forceinline__ float wave_sum(float v) {
#pragma unroll
    for (int o = 1; o < 64; o <<= 1) v += __shfl_xor(v, o);
    return v;
}
__device__ __forceinline__ void transpose_item(const float* W, int K, int N, bf16* WT, int dst_row0, int k0, int n0, LAS float* scr, int lane) {
    { const int rr = lane >> 3, c4 = (lane & 7) * 4;
      f32x4 t[8];
#pragma unroll
      for (int i = 0; i < 8; ++i) t[i] = *(const f32x4*)(W + (size_t)(k0 + 8 * i + rr) * N + n0 + c4);
#pragma unroll
      for (int i = 0; i < 8; ++i) { LAS float* d = scr + (8 * i + rr) * 33 + c4; d[0] = t[i][0]; d[1] = t[i][1]; d[2] = t[i][2]; d[3] = t[i][3]; } }
    asm volatile("s_waitcnt lgkmcnt(0)" ::: "memory");
    const int c = lane & 7;
#pragma unroll
    for (int j = 0; j < 4; ++j) { const int n = (lane >> 3) + 8 * j; const LAS float* s = scr + (8 * c) * 33 + n;
        v4u o; o.x = pk2(s[0 * 33], s[1 * 33]); o.y = pk2(s[2 * 33], s[3 * 33]); o.z = pk2(s[4 * 33], s[5 * 33]); o.w = pk2(s[6 * 33], s[7 * 33]);
        *(v4u*)(WT + (size_t)(dst_row0 + n) * K + k0 + 8 * c) = o; }
    asm volatile("s_waitcnt lgkmcnt(0)" ::: "memory");
}
__device__ __forceinline__ int win_row(int n0) {
    const int pn = n0 >> 8; const bool rope = (pn <= 4) || (pn >= 6 && pn <= 13);
    if (!rope) return n0;
    const int rem = n0 & 255; return (pn << 8) + (((rem & 127) >> 6) << 7) + ((rem >> 7) << 6) + (rem & 63);
}
__device__ __forceinline__ void ld_row_f32(const float* p, int lane, f32x4 (&v)[8]) {
#pragma unroll
    for (int j = 0; j < 4; ++j) { const f32x4* q = (const f32x4*)(p + 8 * (lane + 64 * j)); v[2 * j] = q[0]; v[2 * j + 1] = q[1]; }
}
__device__ __forceinline__ void st_row_f32(float* p, int lane, const f32x4 (&v)[8]) {
#pragma unroll
    for (int j = 0; j < 4; ++j) { f32x4* q = (f32x4*)(p + 8 * (lane + 64 * j)); q[0] = v[2 * j]; q[1] = v[2 * j + 1]; }
}
__device__ __forceinline__ void ld_row_bf16(const bf16* p, int lane, f32x4 (&v)[8]) {
#pragma unroll
    for (int j = 0; j < 4; ++j) { const v4u w = *(const v4u*)(p + 8 * (lane + 64 * j));
        v[2 * j] = (f32x4){pg8::bf_lo(w.x), pg8::bf_hi(w.x), pg8::bf_lo(w.y), pg8::bf_hi(w.y)}; v[2 * j + 1] = (f32x4){pg8::bf_lo(w.z), pg8::bf_hi(w.z), pg8::bf_lo(w.w), pg8::bf_hi(w.w)}; }
}
__device__ __forceinline__ void st_row_bf16(bf16* p, int lane, const f32x4 (&v)[8]) {
#pragma unroll
    for (int j = 0; j < 4; ++j) { v4u w; w.x = pk2(v[2 * j][0], v[2 * j][1]); w.y = pk2(v[2 * j][2], v[2 * j][3]); w.z = pk2(v[2 * j + 1][0], v[2 * j + 1][1]); w.w = pk2(v[2 * j + 1][2], v[2 * j + 1][3]);
        *(v4u*)(p + 8 * (lane + 64 * j)) = w; }
}
__device__ __forceinline__ float row_rstd(const f32x4 (&v)[8]) {
    float s = 0.f;
#pragma unroll
    for (int j = 0; j < 8; ++j) s += (v[j][0] * v[j][0] + v[j][1] * v[j][1]) + (v[j][2] * v[j][2] + v[j][3] * v[j][3]);
    return __builtin_amdgcn_rsqf(wave_sum(s) * (1.0f / DM) + EPS);
}
__device__ __forceinline__ void ld_row_raw(const bf16* p, int lane, v4u (&w)[4]) {
#pragma unroll
    for (int j = 0; j < 4; ++j) w[j] = *(const v4u*)(p + 8 * (lane + 64 * j));
}
__device__ __forceinline__ void unpack_row(const v4u (&w)[4], f32x4 (&v)[8]) {
#pragma unroll
    for (int j = 0; j < 4; ++j) { v[2 * j] = (f32x4){pg8::bf_lo(w[j].x), pg8::bf_hi(w[j].x), pg8::bf_lo(w[j].y), pg8::bf_hi(w[j].y)}; v[2 * j + 1] = (f32x4){pg8::bf_lo(w[j].z), pg8::bf_hi(w[j].z), pg8::bf_lo(w[j].w), pg8::bf_hi(w[j].w)}; }
}
template <bool BB, bool OB>
__device__ __forceinline__ void residual_rows(const bf16* F, const void* basev, void* outv, const float* g_post, float alpha, const float* g_next, bf16* XN, int gw, int NGW, int lane) {
    const char* base = (const char*)basev; char* out = (char*)outv;
    v4u fw[4], bw[4]; f32x4 b[8];
    f32x4 gp[8], gn[8];
    ld_row_f32(g_post, lane, gp); if (XN) ld_row_f32(g_next, lane, gn);
    int m = gw;
    if (m < M) { ld_row_raw(F + (size_t)m * DM, lane, fw);
        if (BB) ld_row_raw((const bf16*)(base + (size_t)m * 8192), lane, bw); else ld_row_f32((const float*)(base + (size_t)m * 8192), lane, b); }
    for (; m < M; m += NGW) {
        const int mn = m + NGW; const bool more = mn < M;
        v4u fwn[4], bwn[4]; f32x4 bn[8];
        if (more) { ld_row_raw(F + (size_t)mn * DM, lane, fwn);
            if (BB) ld_row_raw((const bf16*)(base + (size_t)mn * 8192), lane, bwn); else ld_row_f32((const float*)(base + (size_t)mn * 8192), lane, bn); }
        f32x4 f[8];
        unpack_row(fw, f); if (BB) unpack_row(bw, b);
        const float r1 = row_rstd(f) * alpha;
#pragma unroll
        for (int j = 0; j < 8; ++j) b[j] = b[j] + f[j] * r1 * gp[j];
        if (OB) st_row_bf16((bf16*)(out + (size_t)m * 8192), lane, b); else st_row_f32((float*)(out + (size_t)m * 8192), lane, b);
        if (XN) { const float r2 = row_rstd(b);
#pragma unroll
            for (int j = 0; j < 8; ++j) b[j] = b[j] * r2 * gn[j];
            st_row_bf16(XN + (size_t)m * DM, lane, b); }
        if (more) {
#pragma unroll
            for (int j = 0; j < 4; ++j) { fw[j] = fwn[j]; if (BB) bw[j] = bwn[j]; }
            if (!BB) {
#pragma unroll
                for (int j = 0; j < 8; ++j) b[j] = bn[j]; } }
    }
}

#define XB_TMO      128
#define XB_XCNT(j)  (256  + 64 * (j))
#define XB_XSUB(j)  (1280 + 64 * (j))
#define XB_XGEN(j)  (2304 + 64 * (j))
#define XB_TOP      3328
#define XB_TOPGEN   3392
#define XCD_BAR_WORDS 3456
#define XB_SPIN_CAP (1u << 18)

__device__ __forceinline__ unsigned xb_ld(unsigned* p)              { return __hip_atomic_load(p, __ATOMIC_RELAXED, __HIP_MEMORY_SCOPE_AGENT); }
__device__ __forceinline__ unsigned xb_add(unsigned* p, unsigned v) { return __hip_atomic_fetch_add(p, v, __ATOMIC_RELAXED, __HIP_MEMORY_SCOPE_AGENT); }
__device__ __forceinline__ unsigned xb_xcc_id() { return (unsigned)__builtin_amdgcn_s_getreg((3 << 11) | 20) & 0xFu; }
#define XB_SPIN(cond, bar) do { unsigned _sp = 0; while (cond) { __builtin_amdgcn_s_sleep(1); \
    if ((++_sp & 255u) == 0u) { if (xb_ld(&(bar)[XB_TMO])) break; if (_sp > XB_SPIN_CAP) { atomicAdd(&(bar)[XB_TMO], 1u); break; } } } } while (0)

struct XcdBarrier {
    unsigned* bar; unsigned x;
    volatile LAS unsigned* st;
};

__device__ __forceinline__ XcdBarrier xcd_barrier_post(unsigned* bar, volatile LAS unsigned* st) {
    XcdBarrier b; b.bar = bar; b.x = xb_xcc_id(); b.st = st;
    if (threadIdx.x == 0) (void)xb_add(&bar[XB_XCNT(b.x)], 1u);
    return b;
}
__device__ __forceinline__ void xcd_barrier_complete(unsigned* bar, unsigned x, unsigned& nloc, unsigned& nx) {
    const unsigned G = gridDim.x * gridDim.y * gridDim.z;
    unsigned sum, cnt, mine, sp = 0u;
    for (;;) {
        sum = 0u; cnt = 0u; mine = 0u;
#pragma unroll
        for (unsigned j = 0; j < 16; ++j) { const unsigned c = xb_ld(&bar[XB_XCNT(j)]); sum += c; cnt += (c > 0u) ? 1u : 0u; mine = (j == x) ? c : mine; }
        if (sum == G) break;
        __builtin_amdgcn_s_sleep(1);
        if ((++sp & 255u) == 0u) { if (xb_ld(&bar[XB_TMO])) break; if (sp > XB_SPIN_CAP) { atomicAdd(&bar[XB_TMO], 1u); break; } }
    }
    nloc = mine > 0u ? mine : 1u; nx = cnt > 0u ? cnt : 1u;
}

__device__ __forceinline__ void xcd_barrier(const XcdBarrier& b) {
    asm volatile("s_waitcnt vmcnt(0)" ::: "memory");
    __syncthreads();
    if (threadIdx.x == 0) {
        unsigned* bar = b.bar;
        __builtin_amdgcn_s_waitcnt(0);
        unsigned nloc = b.st[0], nx = b.st[1];
        if (nloc == 0u) { xcd_barrier_complete(bar, b.x, nloc, nx); b.st[0] = nloc; b.st[1] = nx; }
        const unsigned old = xb_add(&bar[XB_XSUB(b.x)], 1u);
        const unsigned gen = old / nloc;
        if (old + 1u == (gen + 1u) * nloc) {
            __builtin_amdgcn_fence(__ATOMIC_RELEASE, "agent");
            asm volatile("s_waitcnt vmcnt(0)" ::: "memory");
            const unsigned og = xb_add(&bar[XB_TOP], 1u);
            const unsigned tg = og / nx;
            if (og + 1u == (tg + 1u) * nx) xb_add(&bar[XB_TOPGEN], 1u);
            else XB_SPIN(xb_ld(&bar[XB_TOPGEN]) == tg, bar);
            __builtin_amdgcn_fence(__ATOMIC_ACQUIRE, "agent");
            xb_add(&bar[XB_XGEN(b.x)], 1u);
            asm volatile("s_waitcnt vmcnt(0)" ::: "memory");
        } else {
            XB_SPIN(xb_ld(&bar[XB_XGEN(b.x)]) == gen, bar);
            __builtin_amdgcn_fence(__ATOMIC_ACQUIRE, "agent");
            asm volatile("s_waitcnt vmcnt(0)" ::: "memory");
        }
    }
    __syncthreads();
}

struct Args { const float* in[24]; float* out; unsigned char* ws; int ph_lo, ph_hi; };

__global__ void __launch_bounds__(NWAVES * 64, 2) mk_fwd(Args args) {
    extern __shared__ __attribute__((aligned(16))) unsigned char lds[];
    cg::grid_group grid = cg::this_grid();
    const int tid = threadIdx.x, lane = tid & 63, wave = __builtin_amdgcn_readfirstlane(tid >> 6);
    const int G = gridDim.x, bx = blockIdx.x, vcu = (G % 8 == 0) ? (bx % 8) * (G / 8) + bx / 8 : bx;
    const int gw = vcu * NWAVES + wave, NGW = G * NWAVES;
    unsigned char* ws = args.ws;
    const float* x = args.in[0]; float* out = args.out;
    bf16* W1GU = (bf16*)(ws + WS_W1GU); bf16* W1D = (bf16*)(ws + WS_W1D); bf16* W2GU = (bf16*)(ws + WS_W2GU); bf16* W2D = (bf16*)(ws + WS_W2D);
    bf16* WIN = (bf16*)(ws + WS_WIN); bf16* WPA = (bf16*)(ws + WS_WPA); bf16* WPB = (bf16*)(ws + WS_WPB); bf16* WOUT = (bf16*)(ws + WS_WOUT);
    float* cosT = (float*)(ws + WS_COS); float* sinT = (float*)(ws + WS_SIN);
    bf16* RB = (bf16*)(ws + WS_B); bf16* RC = (bf16*)(ws + WS_C); bf16* RD = (bf16*)(ws + WS_D);
    bf16* OA = RB; bf16* OB = RB + (size_t)M * 1024;
    bf16* GA = RD; bf16* GB = RD + (size_t)64 * MiB; bf16* QB = RD + (size_t)128 * MiB; bf16* KB = RD + (size_t)160 * MiB; bf16* VB = RD + (size_t)192 * MiB;
    bf16* QA = RD + (size_t)224 * MiB; bf16* KA = RD + (size_t)256 * MiB; bf16* VA = RD + (size_t)264 * MiB;
    LAS unsigned char* ldsl = (LAS unsigned char*)lds;
    const int lo = args.ph_lo, hi = args.ph_hi;
    volatile LAS unsigned* bst = (volatile LAS unsigned*)(ldsl + 133120 + 64);
    if (tid < 2) bst[tid] = 0u;
    __syncthreads();
    if (blockIdx.x == 0) { unsigned* cw = (unsigned*)(ws + WS_CTL); for (int i = tid; i < XCD_BAR_WORDS; i += NWAVES * 64) cw[i] = 0u; }
    asm volatile("s_waitcnt vmcnt(0)" ::: "memory"); __syncthreads();
    grid.sync();
    XcdBarrier bar = xcd_barrier_post((unsigned*)(ws + WS_CTL), bst);
#ifndef PH_MASK
#define PH_MASK 0x3fff
#endif
#define IN(k) (((PH_MASK >> (k)) & 1) && lo <= (k) && (k) < hi)
#ifndef ATT_REP
#define ATT_REP 1
#endif
#ifndef PROBE_TWICE
#define PROBE_TWICE 0
#endif
#define REP(k) for (int rep_ = 0; rep_ < 1 + ((PROBE_TWICE >> (k)) & 1); ++rep_)
#define SEAM(k) do { if (IN(k) && IN((k) + 1)) xcd_barrier(bar); } while (0)

    if (IN(0)) REP(0) {
        LAS float* scr = (LAS float*)(ldsl + wave * 16384);
        constexpr int C_GU = (DM / 64) * (FF / 32), C_D = (FF / 64) * (DM / 32), C_IN = (DM / 64) * (WIN_COLS / 32), C_P = (1024 / 64) * (DM / 32), C_O = (DM / 64) * (DM / 32);
        constexpr int NITEMS = 4 * C_GU + 2 * C_D + C_IN + 2 * C_P + C_O;
        for (int it = gw; it < NITEMS; it += NGW) {
            int r = it;
#define TR_MAT(SRC, KK, NN, DST, CNT, ROWEXPR) if (r < (CNT)) { const int nblk = (NN) / 32, kb = r / nblk, n0 = (r % nblk) * 32; transpose_item(SRC, KK, NN, DST, (ROWEXPR), kb * 64, n0, scr, lane); continue; } r -= (CNT);
            TR_MAT(args.in[2], DM, FF, W1GU, C_GU, 256 * (n0 >> 7) + (n0 & 127))
            TR_MAT(args.in[3], DM, FF, W1GU, C_GU, 256 * (n0 >> 7) + 128 + (n0 & 127))
            TR_MAT(args.in[4], FF, DM, W1D, C_D, n0)
            TR_MAT(args.in[20], DM, FF, W2GU, C_GU, 256 * (n0 >> 7) + (n0 & 127))
            TR_MAT(args.in[21], DM, FF, W2GU, C_GU, 256 * (n0 >> 7) + 128 + (n0 & 127))
            TR_MAT(args.in[22], FF, DM, W2D, C_D, n0)
            TR_MAT(args.in[7], DM, WIN_COLS, WIN, C_IN, win_row(n0))
            TR_MAT(args.in[15], 1024, DM, WPA, C_P, n0)
            TR_MAT(args.in[16], 1024, DM, WPB, C_P, n0)
            TR_MAT(args.in[17], DM, DM, WOUT, C_O, n0)
#undef TR_MAT
        }
        for (int idx = (vcu * NWAVES * 64 + tid); idx < SEQ * 64; idx += G * NWAVES * 64) {
            const int pos = idx >> 6, i = idx & 63;
            const double inv = exp(-(double)(2 * i) / 128.0 * 9.210340371976184);
            double s, c; sincos((double)pos * inv, &s, &c);
            cosT[idx] = (float)c; sinT[idx] = (float)s;
        }
        f32x4 g[8]; ld_row_f32(args.in[1], lane, g);
        for (int m = gw; m < M; m += NGW) {
            f32x4 v[8]; ld_row_f32(x + (size_t)m * DM, lane, v);
            const float r = row_rstd(v);
#pragma unroll
            for (int j = 0; j < 8; ++j) v[j] = v[j] * r * g[j];
            st_row_bf16(RB + (size_t)m * DM, lane, v);
        }
    }
    SEAM(0);
    if (IN(1)) REP(1) { pg8::Gemm g{RB, W1GU, M, 2 * FF, DM}; pg8::StaticOrder S; S.init(M, 2 * FF, G, bx); pg8::EpiSwiGLU E{RD, FF};
        pg8::gemm_phase<pg8::EpiSwiGLU, pg8::StaticOrder, true, true>(ldsl, g, S, E); }
    SEAM(1);
    if (IN(2)) REP(2) { pg8::Gemm g{RD, W1D, M, DM, FF}; pg8::StaticOrder S; S.init(M, DM, G, bx); pg8::EpiStore E{RC, DM};
        pg8::gemm_phase<pg8::EpiStore, pg8::StaticOrder, true, true>(ldsl, g, S, E); }
    SEAM(2);
    if (IN(3)) REP(3) residual_rows<false, true>(RC, x, out, args.in[5], 0.5f, args.in[6], RB, gw, NGW, lane);
    SEAM(3);
    if (IN(4)) REP(4) { pg8::Gemm g{RB, WIN, M, WIN_COLS, DM}; pg8::StaticOrder S; S.init(M, WIN_COLS, G, bx); pg8::EpiProj E{QA, KA, VA, QB, KB, VB, GA, GB, cosT, sinT, args.in[8]};
        pg8::gemm_phase<pg8::EpiProj, pg8::StaticOrder, true, true>(ldsl, g, S, E); }
    SEAM(4);
    if (IN(5)) REP(5) {

#ifndef NO_DENSE
        for (int id2 = vcu; id2 < 1024 * ATT_REP; id2 += G) { const int id = id2 & 1023;
            const int combo = id >> 6, qb = id & 63, b = combo >> 3, h = (combo >> 1) & 3, c = combo & 1;
            const bf16* Q = QB + ((size_t)(b * 8 + h * 2 + c) * SEQ + qb * 256) * 128;
            const bf16* K = KB + ((size_t)(b * 8 + h * 2 + c) * SEQ) * 128;
            const bf16* V = VB + ((size_t)(b * 4 + h) * SEQ) * 256;
            bf16* O = RC + (size_t)(b * SEQ + qb * 256) * 2048 + h * 512 + c * 256;
            att::attn_unit_dv<2048>(Q, K, V, O, SEQ / 64, (char*)lds, ldsl);
        }
#endif
#ifndef NO_WIN
        for (int id = vcu; id < 1024; id += G) {
            const int qb = id & 63, hq = (id >> 6) & 7, b = id >> 9, g = hq >> 2, q0 = qb * 256;
            const int klo = q0 >= 128 ? q0 - 128 : 0, khi = (q0 + 384 <= SEQ) ? q0 + 384 : SEQ;
            const bf16* Q = QA + ((size_t)(b * 8 + hq) * SEQ + q0) * 128;
            const bf16* K = KA + ((size_t)(b * 2 + g) * SEQ + klo) * 128;
            const bf16* V = VA + ((size_t)(b * 2 + g) * SEQ + klo) * 128;
            bf16* O = OA + (size_t)(b * SEQ + q0) * 1024 + hq * 128;
            att::attn_unit<true, 1024>(Q, K, V, O, (khi - klo) / 64, q0 - klo, args.in[9][hq] * (1.0f / att::SCALE), 1.f, (char*)lds);
        }
#endif
    }
    SEAM(5);
    if (IN(6)) REP(6) {
        const float a1 = wave_sum(args.in[10][lane] * args.in[11][lane] + args.in[10][lane + 64] * args.in[11][lane + 64]);
        const float a2 = wave_sum(args.in[12][lane] * args.in[13][lane] + args.in[12][lane + 64] * args.in[13][lane + 64]);
        const float lam = expf(a1) - expf(a2) + 0.2f;
        const int h = lane >> 4, e0 = (lane & 15) * 16;
        f32x4 sg[4];
#pragma unroll
        for (int j = 0; j < 4; ++j) sg[j] = *(const f32x4*)(args.in[14] + e0 + 4 * j) * 0.8f;
        for (int m = gw; m < M; m += NGW) {
            const bf16* p = RC + (size_t)m * 2048 + h * 512 + e0;
            const v4u w0 = *(const v4u*)p, w1 = *(const v4u*)(p + 8), u0 = *(const v4u*)(p + 256), u1 = *(const v4u*)(p + 264);
            f32x4 d[4];
            d[0] = (f32x4){pg8::bf_lo(w0.x), pg8::bf_hi(w0.x), pg8::bf_lo(w0.y), pg8::bf_hi(w0.y)} - lam * (f32x4){pg8::bf_lo(u0.x), pg8::bf_hi(u0.x), pg8::bf_lo(u0.y), pg8::bf_hi(u0.y)};
            d[1] = (f32x4){pg8::bf_lo(w0.z), pg8::bf_hi(w0.z), pg8::bf_lo(w0.w), pg8::bf_hi(w0.w)} - lam * (f32x4){pg8::bf_lo(u0.z), pg8::bf_hi(u0.z), pg8::bf_lo(u0.w), pg8::bf_hi(u0.w)};
            d[2] = (f32x4){pg8::bf_lo(w1.x), pg8::bf_hi(w1.x), pg8::bf_lo(w1.y), pg8::bf_hi(w1.y)} - lam * (f32x4){pg8::bf_lo(u1.x), pg8::bf_hi(u1.x), pg8::bf_lo(u1.y), pg8::bf_hi(u1.y)};
            d[3] = (f32x4){pg8::bf_lo(w1.z), pg8::bf_hi(w1.z), pg8::bf_lo(w1.w), pg8::bf_hi(w1.w)} - lam * (f32x4){pg8::bf_lo(u1.z), pg8::bf_hi(u1.z), pg8::bf_lo(u1.w), pg8::bf_hi(u1.w)};
            float s = 0.f;
#pragma unroll
            for (int j = 0; j < 4; ++j) s += (d[j][0] * d[j][0] + d[j][1] * d[j][1]) + (d[j][2] * d[j][2] + d[j][3] * d[j][3]);
            s += __shfl_xor(s, 1); s += __shfl_xor(s, 2); s += __shfl_xor(s, 4); s += __shfl_xor(s, 8);
            const float r = 1.0f / sqrtf(s * (1.0f / 256.0f) + EPS);
#pragma unroll
            for (int j = 0; j < 4; ++j) d[j] = d[j] * r * sg[j];
            v4u o0, o1; o0.x = pk2(d[0][0], d[0][1]); o0.y = pk2(d[0][2], d[0][3]); o0.z = pk2(d[1][0], d[1][1]); o0.w = pk2(d[1][2], d[1][3]);
            o1.x = pk2(d[2][0], d[2][1]); o1.y = pk2(d[2][2], d[2][3]); o1.z = pk2(d[3][0], d[3][1]); o1.w = pk2(d[3][2], d[3][3]);
            bf16* q = OB + (size_t)m * 1024 + h * 256 + e0; *(v4u*)q = o0; *(v4u*)(q + 8) = o1;
        }
    }
    SEAM(6);
    if (IN(7)) REP(7) { pg8::Gemm g{OA, WPA, M, DM, 1024}; pg8::StaticOrder S; S.init(M, DM, G, bx); pg8::EpiGate<0> E{RC, GA};
        pg8::gemm_phase<pg8::EpiGate<0>, pg8::StaticOrder, true, true>(ldsl, g, S, E); }
    SEAM(7);
    if (IN(8)) REP(8) { pg8::Gemm g{OB, WPB, M, DM, 1024}; pg8::StaticOrder S; S.init(M, DM, G, bx); pg8::EpiGate<1> E{RC, GB};
        pg8::gemm_phase<pg8::EpiGate<1>, pg8::StaticOrder, true, true>(ldsl, g, S, E); }
    SEAM(8);
    if (IN(9)) REP(9) { pg8::Gemm g{RC, WOUT, M, DM, DM}; pg8::StaticOrder S; S.init(M, DM, G, bx); pg8::EpiStore E{RB, DM};
        pg8::gemm_phase<pg8::EpiStore, pg8::StaticOrder, true, true>(ldsl, g, S, E); }
    SEAM(9);
    if (IN(10)) REP(10) residual_rows<true, true>(RB, out, out, args.in[18], 1.0f, args.in[19], RC, gw, NGW, lane);
    SEAM(10);
    if (IN(11)) REP(11) { pg8::Gemm g{RC, W2GU, M, 2 * FF, DM}; pg8::StaticOrder S; S.init(M, 2 * FF, G, bx); pg8::EpiSwiGLU E{RD, FF};
        pg8::gemm_phase<pg8::EpiSwiGLU, pg8::StaticOrder, true, true>(ldsl, g, S, E); }
    SEAM(11);
    if (IN(12)) REP(12) { pg8::Gemm g{RD, W2D, M, DM, FF}; pg8::StaticOrder S; S.init(M, DM, G, bx); pg8::EpiStore E{RB, DM};
        pg8::gemm_phase<pg8::EpiStore, pg8::StaticOrder, true, true>(ldsl, g, S, E); }
    SEAM(12);
    if (IN(13)) REP(13) residual_rows<true, false>(RB, out, out, args.in[23], 0.5f, nullptr, nullptr, gw, NGW, lane);
#undef IN
#undef SEAM
}

extern "C" void kernel_launch(void* const* d_in, const int* in_sizes, int n_in, void* d_out, int out_size, void* d_ws, size_t ws_size, hipStream_t stream) {
    static int grid = 0;
    if (grid == 0) {
        if (n_in != 24 || in_sizes[0] != M * DM || out_size != M * DM || ws_size < WS_END) { fprintf(stderr, "kernel_launch: shape/workspace mismatch (n_in %d, in0 %d, out %d, ws %zu < %zu)\n", n_in, n_in > 0 ? in_sizes[0] : -1, out_size, ws_size, (size_t)WS_END); grid = -1; return; }
        int dev = 0, cus = 0, per_cu = 0;
        if (hipGetDevice(&dev) != hipSuccess || hipDeviceGetAttribute(&cus, hipDeviceAttributeMultiprocessorCount, dev) != hipSuccess) { grid = -1; return; }
        if (hipFuncSetAttribute((const void*)mk_fwd, hipFuncAttributeMaxDynamicSharedMemorySize, LDS_BYTES) != hipSuccess) { fprintf(stderr, "kernel_launch: hipFuncSetAttribute failed\n"); grid = -1; return; }
        if (hipOccupancyMaxActiveBlocksPerMultiprocessor(&per_cu, (const void*)mk_fwd, NWAVES * 64, LDS_BYTES) != hipSuccess || per_cu < 1) { fprintf(stderr, "kernel_launch: occupancy query says %d\n", per_cu); per_cu = 1; }
        (void)hipGetLastError();
        grid = cus * per_cu;
    }
    if (grid < 0) return;
    Args a{};
    for (int i = 0; i < 24; ++i) a.in[i] = (const float*)d_in[i];
    a.out = (float*)d_out; a.ws = (unsigned char*)d_ws;
#if MK_PER_PHASE
    for (int p = 0; p < PH_LIMIT; ++p) { a.ph_lo = p; a.ph_hi = p + 1; hipLaunchKernelGGL(mk_fwd, dim3(grid), dim3(NWAVES * 64), LDS_BYTES, stream, a); }
#else
    a.ph_lo = 0; a.ph_hi = NPHASE;
    void* kargs[] = {&a};
    const hipError_t e = hipLaunchCooperativeKernel((const void*)mk_fwd, dim3(grid), dim3(NWAVES * 64), kargs, LDS_BYTES, stream);
    if (e != hipSuccess) fprintf(stderr, "kernel_launch: cooperative launch failed: %s (grid %d)\n", hipGetErrorString(e), grid);
#endif
}
```

```cpp
#include <hip/hip_runtime.h>
#include <hip/hip_bf16.h>
#include <hip/hip_cooperative_groups.h>
#include <cstdio>
#include <cstdint>
#include <cmath>
namespace cg = cooperative_groups;
namespace pg8 {
#define PG8_LAS __attribute__((address_space(3)))
typedef unsigned short bf16_t;
typedef short bf16x8 __attribute__((ext_vector_type(8)));
typedef float f32x4 __attribute__((ext_vector_type(4)));
typedef unsigned u32x4 __attribute__((ext_vector_type(4)));
constexpr int BM = 256, BK = 64, HALF = 128, HTB = HALF * BK * 2  , STAGE_BYTES = 8 * HTB, NXCD = 8, WGM = 8;

__host__ __device__ __forceinline__ int lds_byte(int r, int c) { const int st = (r >> 4) * 2 + (c >> 5), rr = r & 15, cc = c & 31, ob = rr * 64 + cc * 2; return st * 1024 + (ob ^ (((ob >> 9) & 1) << 5)); }
__host__ __device__ __forceinline__ void stage_rc(int b, int& R, int& C) { const int st = b / 1024, sb = b % 1024, swz = sb ^ (((sb >> 9) & 1) << 5); R = (st >> 1) * 16 + swz / 64; C = (st & 1) * 32 + (swz % 64) / 2; }
__host__ __device__ __forceinline__ int perm32(int rho) { const int n = rho >> 4, i = rho & 15; return 8 * (i >> 2) + 4 * n + (i & 3); }

struct Unit { int pm, pn; };
struct Gemm { const bf16_t* A; const bf16_t* Bt; int M, N, K; };

struct StaticOrder {
    int nM, nN, nwg, G, c;
    __host__ __device__ void init(int M, int N, int G_, int c_) { nM = M / BM; nN = N / BM; nwg = nM * nN; G = G_; c = c_; }
    __host__ __device__ bool next(int i, Unit& u) const {
        const long L = (long)i * G + c; if (L >= nwg) return false;
        int wgid = (int)L; { const int q = nwg / NXCD, r = nwg % NXCD, xcd = wgid % NXCD, off = wgid / NXCD; wgid = (xcd < r ? xcd * (q + 1) : r * (q + 1) + (xcd - r) * q) + off; }
        const int nig = WGM * nN, gid = wgid / nig, fm = gid * WGM, gsz = (nM - fm) < WGM ? (nM - fm) : WGM;
        u.pm = fm + ((wgid % nig) % gsz); u.pn = (wgid % nig) / gsz; return true;
    }
    __device__ __forceinline__ void a_ready(const Unit&) const {}
    __device__ __forceinline__ void done(const Unit&) const {}
};
typedef float f32x2_t __attribute__((ext_vector_type(2))); typedef __bf16 bf16x2_t __attribute__((ext_vector_type(2)));
__device__ __forceinline__ unsigned cvt_pk_bf16(float lo, float hi) { f32x2_t v = {lo, hi}; bf16x2_t b = __builtin_convertvector(v, bf16x2_t); return __builtin_bit_cast(unsigned, b); }
typedef float f32x2 __attribute__((ext_vector_type(2)));
__device__ __forceinline__ float bf_lo(unsigned w) { return __uint_as_float(w << 16); }
__device__ __forceinline__ float bf_hi(unsigned w) { return __uint_as_float(w & 0xffff0000u); }
__device__ __forceinline__ u32x4 pack8(const f32x4 a, const f32x4 b) { u32x4 w; w.x = cvt_pk_bf16(a[0], a[1]); w.y = cvt_pk_bf16(a[2], a[3]); w.z = cvt_pk_bf16(b[0], b[1]); w.w = cvt_pk_bf16(b[2], b[3]); return w; }
__device__ __forceinline__ float sigmoid_f(float v) { return __builtin_amdgcn_rcpf(1.0f + __builtin_amdgcn_exp2f(-1.4426950408889634f * v)); }

struct EpiStore {
    static constexpr bool PERM = true, AFTER_DRAIN = false;
    bf16_t* O; int ldc;
    __device__ __forceinline__ void operator()(const f32x4 (&acc)[2][2][4][2], const Unit& u, int wr, int wc, int fr, int fq) const {
        const int row0 = u.pm * BM + wr * 64 + fr, col0 = u.pn * BM + wc * 32 + 8 * fq;
#pragma unroll
        for (int ai = 0; ai < 2; ++ai)
#pragma unroll
            for (int m = 0; m < 4; ++m) { bf16_t* rowp = O + (size_t)(row0 + ai * HALF + m * 16) * ldc + col0;
#pragma unroll
                for (int bj = 0; bj < 2; ++bj) *(u32x4*)(rowp + bj * HALF) = pack8(acc[ai][bj][m][0], acc[ai][bj][m][1]); }
    }
};
struct EpiSwiGLU {
    static constexpr bool PERM = true, AFTER_DRAIN = false;
    bf16_t* O; int ldc;
    __device__ __forceinline__ void operator()(const f32x4 (&acc)[2][2][4][2], const Unit& u, int wr, int wc, int fr, int fq) const {
        const int row0 = u.pm * BM + wr * 64 + fr, col0 = u.pn * HALF + wc * 32 + 8 * fq;
#pragma unroll
        for (int ai = 0; ai < 2; ++ai)
#pragma unroll
            for (int m = 0; m < 4; ++m) { f32x4 h[2];
#pragma unroll
                for (int n = 0; n < 2; ++n) { const f32x4 g = acc[ai][0][m][n], v = acc[ai][1][m][n];
#pragma unroll
                    for (int e = 0; e < 4; ++e) h[n][e] = g[e] * sigmoid_f(g[e]) * v[e]; }
                *(u32x4*)(O + (size_t)(row0 + ai * HALF + m * 16) * ldc + col0) = pack8(h[0], h[1]); }
    }
};
struct EpiProj {
    static constexpr bool PERM = true, AFTER_DRAIN = false;
    bf16_t *QA, *KA, *VA, *QB, *KB, *VB, *GA, *GB; const float* cosT; const float* sinT; const float* gbias;
    __device__ __forceinline__ void operator()(const f32x4 (&acc)[2][2][4][2], const Unit& u, int wr, int wc, int fr, int fq) const {
        const int pn = u.pn, row0 = u.pm * BM + wr * 64 + fr;
        const bool rope = (pn <= 4) || (pn >= 6 && pn <= 13);
        if (rope) {
            const int i0 = (wc & 1) * 32 + 8 * fq, hl = wc >> 1;
            bf16_t* hb; int nh, hd;
            if (pn <= 3) { hb = QA; nh = 8; hd = 2 * pn + hl; } else if (pn == 4) { hb = KA; nh = 2; hd = hl; } else if (pn <= 9) { hb = QB; nh = 8; hd = 2 * (pn - 6) + hl; } else { hb = KB; nh = 8; hd = 2 * (pn - 10) + hl; }
#pragma unroll
            for (int ai = 0; ai < 2; ++ai)
#pragma unroll
                for (int m = 0; m < 4; ++m) { const int row = row0 + ai * HALF + m * 16, pos = row & 16383, b = row >> 14;
                    const f32x4* cp = (const f32x4*)(cosT + (size_t)pos * 64 + i0); const f32x4* sp = (const f32x4*)(sinT + (size_t)pos * 64 + i0);
                    f32x4 y1[2], y2[2];
#pragma unroll
                    for (int n = 0; n < 2; ++n) { const f32x4 c = cp[n], s = sp[n], x1 = acc[ai][0][m][n], x2 = acc[ai][1][m][n]; y1[n] = x1 * c - x2 * s; y2[n] = x2 * c + x1 * s; }
                    bf16_t* rowp = hb + ((size_t)(b * nh + hd) * 16384 + pos) * 128 + i0;
                    *(u32x4*)(rowp) = pack8(y1[0], y1[1]); *(u32x4*)(rowp + 64) = pack8(y2[0], y2[1]); }
        } else if (pn < 18) {
            const int dcol = wc * 32 + 8 * fq;
#pragma unroll
            for (int ai = 0; ai < 2; ++ai)
#pragma unroll
                for (int m = 0; m < 4; ++m) { const int row = row0 + ai * HALF + m * 16, pos = row & 16383, b = row >> 14;
#pragma unroll
                    for (int bj = 0; bj < 2; ++bj) {
                        bf16_t* dst = (pn == 5) ? VA + ((size_t)(b * 2 + bj) * 16384 + pos) * 128 + dcol
                                                : VB + ((size_t)(b * 4 + (pn - 14)) * 16384 + pos) * 256 + bj * HALF + dcol;
                        *(u32x4*)dst = pack8(acc[ai][bj][m][0], acc[ai][bj][m][1]); } }
        } else {
            const int col0 = pn * BM + wc * 32 + 8 * fq;
            bf16_t* gbuf = (pn < 26) ? GA : GB; const int gcol0 = (pn < 26 ? (pn - 18) : (pn - 26)) * BM + wc * 32 + 8 * fq;
            f32x4 bv[2][2];
#pragma unroll
            for (int bj = 0; bj < 2; ++bj)
#pragma unroll
                for (int n = 0; n < 2; ++n) bv[bj][n] = *(const f32x4*)(gbias + (col0 - 4608) + bj * HALF + 4 * n);
#pragma unroll
            for (int ai = 0; ai < 2; ++ai)
#pragma unroll
                for (int m = 0; m < 4; ++m) { bf16_t* rowp = gbuf + (size_t)(row0 + ai * HALF + m * 16) * 2048 + gcol0;
#pragma unroll
                    for (int bj = 0; bj < 2; ++bj) { f32x4 v[2];
#pragma unroll
                        for (int n = 0; n < 2; ++n) { const f32x4 t = acc[ai][bj][m][n] + bv[bj][n];
#pragma unroll
                            for (int e = 0; e < 4; ++e) v[n][e] = sigmoid_f(t[e]); }
                        *(u32x4*)(rowp + bj * HALF) = pack8(v[0], v[1]); } }
        }
    }
};
template <int PASS> struct EpiGate {
    static constexpr bool PERM = true, AFTER_DRAIN = false;
    bf16_t* T; const bf16_t* gate;
    __device__ __forceinline__ void operator()(const f32x4 (&acc)[2][2][4][2], const Unit& u, int wr, int wc, int fr, int fq) const {
        const int row0 = u.pm * BM + wr * 64 + fr, col0 = u.pn * BM + wc * 32 + 8 * fq;
#pragma unroll
        for (int ai = 0; ai < 2; ++ai) {
            u32x4 gw[4][2], tw[4][2];
#pragma unroll
            for (int m = 0; m < 4; ++m)
#pragma unroll
                for (int bj = 0; bj < 2; ++bj) { const int row = row0 + ai * HALF + m * 16, col = col0 + bj * HALF;
                    gw[m][bj] = *(const u32x4*)(gate + (size_t)row * 2048 + col);
                    if (PASS == 1) tw[m][bj] = *(const u32x4*)(T + (size_t)row * 2048 + col); }
#pragma unroll
            for (int m = 0; m < 4; ++m)
#pragma unroll
                for (int bj = 0; bj < 2; ++bj) { const int row = row0 + ai * HALF + m * 16, col = col0 + bj * HALF;
                    const u32x4 g = gw[m][bj];
                    const f32x4 g0 = {bf_lo(g.x), bf_hi(g.x), bf_lo(g.y), bf_hi(g.y)}, g1 = {bf_lo(g.z), bf_hi(g.z), bf_lo(g.w), bf_hi(g.w)};
                    f32x4 v0 = g0 * acc[ai][bj][m][0], v1 = g1 * acc[ai][bj][m][1];
                    if (PASS == 1) { const u32x4 t = tw[m][bj];
                        v0 += (f32x4){bf_lo(t.x), bf_hi(t.x), bf_lo(t.y), bf_hi(t.y)}; v1 += (f32x4){bf_lo(t.z), bf_hi(t.z), bf_lo(t.w), bf_hi(t.w)}; }
                    *(u32x4*)(T + (size_t)row * 2048 + col) = pack8(v0, v1); }
        }
    }
};

template <class Epi, class Sched, bool ALIGN_EPI = false, bool SP2 = false>
__device__ __forceinline__ void gemm_phase(PG8_LAS unsigned char* lds, const Gemm g, const Sched& S, const Epi& E) {
    const int tid = threadIdx.x, wid = __builtin_amdgcn_readfirstlane(tid >> 6), lane = tid & 63, wr = wid >> 2, wc = wid & 3, fr = lane & 15, fq = lane >> 4;
    const int K = g.K, nt = K / BK;
    unsigned voffA[2], voffB[2];
#pragma unroll
    for (int i = 0; i < 2; ++i) { int R, C; stage_rc(tid * 16 + i * 8192, R, C); const int Rb = Epi::PERM ? ((R & ~31) + perm32(R & 31)) : R;
        voffA[i] = (unsigned)(R * K + C) * 2u; voffB[i] = (unsigned)(Rb * K + C) * 2u; }
    const size_t kstep = (size_t)(BK * 2);
    const size_t hstep = (size_t)HALF * K * 2;
    const size_t tstep = 2 * hstep;
    const unsigned ldsw = (unsigned)wid * 1024u;
    const int aoff = lds_byte(wr * 64 + fr, fq * 8), boff = lds_byte(wc * 32 + fr, fq * 8);
#define PG8_SA(b, h) (((b) * 2 + (h)) * HTB)
#define PG8_SB(b, h) ((4 + (b) * 2 + (h)) * HTB)
#define PG8_STAGE(bufoff, gbase, voff) do { _Pragma("unroll") for (int _i = 0; _i < 2; ++_i) \
        __builtin_amdgcn_global_load_lds((const unsigned*)((const char*)(gbase) + (voff)[_i]), (PG8_LAS unsigned*)(lds + (bufoff) + ldsw + _i * 8192), 16, 0, 0); } while (0)
#define PG8_LDA(dst, b, h) do { _Pragma("unroll") for (int m = 0; m < 4; ++m) _Pragma("unroll") for (int k = 0; k < 2; ++k) dst[m][k] = *(const PG8_LAS bf16x8*)(lds + PG8_SA(b, h) + aoff + m * 2048 + k * 1024); } while (0)
#define PG8_LDB(dst, b, h) do { _Pragma("unroll") for (int n = 0; n < 2; ++n) _Pragma("unroll") for (int k = 0; k < 2; ++k) dst[n][k] = *(const PG8_LAS bf16x8*)(lds + PG8_SB(b, h) + boff + n * 2048 + k * 1024); } while (0)
#define PG8_MMA(ai, bj, At, Bt) do { __builtin_amdgcn_s_setprio(1); _Pragma("unroll") for (int m = 0; m < 4; ++m) _Pragma("unroll") for (int n = 0; n < 2; ++n) _Pragma("unroll") for (int k = 0; k < 2; ++k) \
        acc[ai][bj][m][n] = __builtin_amdgcn_mfma_f32_16x16x32_bf16(Bt[n][k], At[m][k], acc[ai][bj][m][n], 0, 0, 0); __builtin_amdgcn_s_setprio(0); } while (0)
#define PG8_WAIT_V(n) asm volatile("s_waitcnt vmcnt(" #n ")" ::: "memory")
#define PG8_WAIT_L(n) asm volatile("s_waitcnt lgkmcnt(" #n ")" ::: "memory")
#define PG8_BAR __builtin_amdgcn_s_barrier()
#define PG8_SCHED __builtin_amdgcn_sched_barrier(0)
    Unit cur, nxt; int ui = 0;
    if (!S.next(0, cur)) return;
    f32x4 acc[2][2][4][2];
#pragma unroll
    for (int a = 0; a < 2; ++a)
#pragma unroll
        for (int b = 0; b < 2; ++b)
#pragma unroll
            for (int m = 0; m < 4; ++m)
#pragma unroll
                for (int n = 0; n < 2; ++n) acc[a][b][m][n] = (f32x4){0.f, 0.f, 0.f, 0.f};
    bf16x8 At[4][2], B0[2][2], B1[2][2];
    const char* cA = (const char*)g.A + (size_t)cur.pm * tstep; const char* cB = (const char*)g.Bt + (size_t)cur.pn * tstep;
    S.a_ready(cur);
    if constexpr (SP2) {
        PG8_STAGE(PG8_SB(0, 0), cB, voffB); PG8_STAGE(PG8_SB(0, 1), cB + hstep, voffB); PG8_STAGE(PG8_SA(0, 0), cA, voffA); PG8_STAGE(PG8_SA(0, 1), cA + hstep, voffA);
        if (wr == 1) PG8_BAR;
        PG8_WAIT_V(2); PG8_BAR;
        PG8_STAGE(PG8_SB(1, 0), cB + kstep, voffB); PG8_STAGE(PG8_SA(1, 0), cA + kstep, voffA); PG8_STAGE(PG8_SB(1, 1), cB + hstep + kstep, voffB);
        PG8_WAIT_V(6); PG8_BAR;
    } else {
        PG8_STAGE(PG8_SB(0, 0), cB, voffB); PG8_STAGE(PG8_SA(0, 0), cA, voffA); PG8_STAGE(PG8_SB(0, 1), cB + hstep, voffB); PG8_STAGE(PG8_SA(0, 1), cA + hstep, voffA);
        if (wr == 1) PG8_BAR;
        PG8_WAIT_V(4); PG8_BAR;
        PG8_STAGE(PG8_SB(1, 0), cB + kstep, voffB); PG8_STAGE(PG8_SA(1, 0), cA + kstep, voffA); PG8_STAGE(PG8_SB(1, 1), cB + hstep + kstep, voffB);
        PG8_WAIT_V(6); PG8_BAR;
    }
    for (;;) {
        const bool has_next = S.next(ui + 1, nxt);
        const char* nA = has_next ? (const char*)g.A + (size_t)nxt.pm * tstep : cA; const char* nB = has_next ? (const char*)g.Bt + (size_t)nxt.pn * tstep : cB;
        for (int t = 0; t < nt; t += 2) {
            const bool last = (t == nt - 2);
            const char* a1 = cA + (size_t)(t + 1) * kstep;
            const char* a2 = last ? nA : cA + (size_t)(t + 2) * kstep; const char* b2 = last ? nB : cB + (size_t)(t + 2) * kstep;
            const char* a3 = a2 + kstep; const char* b3 = b2 + kstep;
            if (last && has_next) S.a_ready(nxt);
            if constexpr (SP2) {
            PG8_LDB(B0, 0, 0); PG8_LDB(B1, 0, 1); PG8_SCHED; PG8_LDA(At, 0, 0); PG8_STAGE(PG8_SA(1, 1), a1 + hstep, voffA);
            PG8_WAIT_V(8); PG8_WAIT_L(0); PG8_BAR; PG8_MMA(0, 0, At, B0); PG8_MMA(0, 1, At, B1); PG8_BAR; PG8_SCHED;
            PG8_LDA(At, 0, 1); PG8_STAGE(PG8_SB(0, 0), b2, voffB); PG8_STAGE(PG8_SB(0, 1), b2 + hstep, voffB); PG8_STAGE(PG8_SA(0, 0), a2, voffA);
            PG8_WAIT_V(8); PG8_WAIT_L(0); PG8_BAR; PG8_MMA(1, 0, At, B0); PG8_MMA(1, 1, At, B1); PG8_BAR; PG8_SCHED;
            PG8_LDB(B0, 1, 0); PG8_LDB(B1, 1, 1); PG8_SCHED; PG8_LDA(At, 1, 0); PG8_STAGE(PG8_SA(0, 1), a2 + hstep, voffA);
            PG8_WAIT_V(8); PG8_WAIT_L(0); PG8_BAR; PG8_MMA(0, 0, At, B0); PG8_MMA(0, 1, At, B1); PG8_BAR; PG8_SCHED;
            PG8_LDA(At, 1, 1); PG8_STAGE(PG8_SB(1, 0), b3, voffB); PG8_STAGE(PG8_SB(1, 1), b3 + hstep, voffB); PG8_STAGE(PG8_SA(1, 0), a3, voffA);
            PG8_WAIT_V(8); PG8_WAIT_L(0); PG8_BAR; PG8_MMA(1, 0, At, B0); PG8_MMA(1, 1, At, B1); PG8_BAR; PG8_SCHED;
            } else {
            PG8_LDB(B0, 0, 0); PG8_SCHED; PG8_LDA(At, 0, 0); PG8_STAGE(PG8_SA(1, 1), a1 + hstep, voffA);
            PG8_WAIT_L(8); PG8_BAR; PG8_WAIT_L(0); PG8_MMA(0, 0, At, B0); PG8_BAR; PG8_SCHED;
            PG8_LDB(B1, 0, 1); PG8_STAGE(PG8_SB(0, 0), b2, voffB);
            PG8_BAR; PG8_WAIT_L(0); PG8_MMA(0, 1, At, B1); PG8_BAR;
            PG8_LDA(At, 0, 1); PG8_STAGE(PG8_SA(0, 0), a2, voffA);
            PG8_BAR; PG8_WAIT_L(0); PG8_MMA(1, 0, At, B0); PG8_BAR; PG8_SCHED;
            PG8_STAGE(PG8_SB(0, 1), b2 + hstep, voffB);
            PG8_WAIT_V(6); PG8_BAR; PG8_MMA(1, 1, At, B1); PG8_BAR;
            PG8_LDB(B0, 1, 0); PG8_SCHED; PG8_LDA(At, 1, 0); PG8_STAGE(PG8_SA(0, 1), a2 + hstep, voffA);
            PG8_WAIT_L(8); PG8_BAR; PG8_WAIT_L(0); PG8_MMA(0, 0, At, B0); PG8_BAR; PG8_SCHED;
            PG8_LDB(B1, 1, 1); PG8_STAGE(PG8_SB(1, 0), b3, voffB);
            PG8_BAR; PG8_WAIT_L(0); PG8_MMA(0, 1, At, B1); PG8_BAR;
            PG8_LDA(At, 1, 1); PG8_STAGE(PG8_SA(1, 0), a3, voffA);
            PG8_BAR; PG8_WAIT_L(0); PG8_MMA(1, 0, At, B0); PG8_BAR; PG8_SCHED;
            PG8_STAGE(PG8_SB(1, 1), b3 + hstep, voffB);
            PG8_WAIT_V(6); PG8_BAR; PG8_MMA(1, 1, At, B1); PG8_BAR;
            }
        }
        if constexpr (ALIGN_EPI) { if (wr == 0) PG8_BAR; }
        if constexpr (!Epi::AFTER_DRAIN) { E(acc, cur, wr, wc, fr, fq); S.done(cur); }
        if (!has_next) break;
#pragma unroll
        for (int a = 0; a < 2; ++a)
#pragma unroll
            for (int b = 0; b < 2; ++b)
#pragma unroll
                for (int m = 0; m < 4; ++m)
#pragma unroll
                    for (int n = 0; n < 2; ++n) acc[a][b][m][n] = (f32x4){0.f, 0.f, 0.f, 0.f};
        cur = nxt; cA = nA; cB = nB; ++ui;
        if constexpr (ALIGN_EPI) { if (wr == 1) PG8_BAR; }
    }
    PG8_WAIT_V(0);
    if constexpr (!ALIGN_EPI) { if (wr == 0) PG8_BAR; }
    PG8_BAR;
    if constexpr (Epi::AFTER_DRAIN) { E.fused(acc, cur, wr, wc, fr, fq, lds, wid, lane); S.done(cur); }
#undef PG8_SA
#undef PG8_SB
#undef PG8_STAGE
#undef PG8_LDA
#undef PG8_LDB
#undef PG8_MMA
#undef PG8_WAIT_V
#undef PG8_WAIT_L
#undef PG8_BAR
#undef PG8_SCHED
}
}
namespace att {
typedef unsigned short bf16_t;
constexpr int   D = 128, NW = 8, QBLK = 32, KVBLK = 64;
constexpr float SCALE = 0.088388347648318440f;
constexpr float THR = 8.f;
constexpr int   LDQ = 128, LDK = 128, LDV2 = 256;
constexpr size_t SHM_V = KVBLK * D * 2, SHM_K = KVBLK * D * 2, SHM_ATTN = 2 * SHM_V + 2 * SHM_K + NW * 64 * 4;
using bf16x8 = __attribute__((ext_vector_type(8))) short;
using s16x4  = __attribute__((ext_vector_type(4))) short;
using f32x16 = __attribute__((ext_vector_type(16))) float;
using u32x4  = __attribute__((ext_vector_type(4))) unsigned;
#define KSWZ(row, colB) ((row) * 256 + ((colB) ^ (((row) & 7) << 4)))
#define SBAR() __builtin_amdgcn_sched_barrier(0)
__device__ __forceinline__ int crow(int r, int hi) { return (r & 3) + 8 * (r >> 2) + 4 * hi; }
typedef float f32x2a __attribute__((ext_vector_type(2))); typedef __bf16 bf16x2a __attribute__((ext_vector_type(2)));
__device__ __forceinline__ unsigned cvtpk(float lo, float hi) { f32x2a v = {lo, hi}; bf16x2a b = __builtin_convertvector(v, bf16x2a); return __builtin_bit_cast(unsigned, b); }
__device__ __forceinline__ bf16x8 ld8(const bf16_t* p) { return *reinterpret_cast<const bf16x8*>(p); }

template <bool WIN>
__device__ __forceinline__ void partialSM(f32x16& p0, f32x16& p1, float& m_reg, float& mn, float& alpha) {
  constexpr float C = SCALE * 1.4426950408889634f;
  float pmax = p0[0];
#pragma unroll
  for (int r = 1; r < 16; ++r) pmax = fmaxf(pmax, p0[r]);
#pragma unroll
  for (int r = 0; r < 16; ++r) pmax = fmaxf(pmax, p1[r]);
  { auto rr = __builtin_amdgcn_permlane32_swap(__float_as_uint(pmax), __float_as_uint(pmax), false, false);
    pmax = fmaxf(__uint_as_float(rr[0]), __uint_as_float(rr[1])); }
  if (__builtin_expect(__all(pmax - m_reg <= THR / SCALE), 1)) { mn = m_reg; alpha = 1.f; }
  else { mn = fmaxf(m_reg, pmax); alpha = __builtin_amdgcn_exp2f((m_reg - mn) * C); m_reg = mn; }
  float mnC = -mn * C;
#pragma unroll
  for (int r = 0; r < 16; ++r) p0[r] = fmaf(p0[r], C, mnC);
#pragma unroll
  for (int r = 0; r < 16; ++r) p1[r] = fmaf(p1[r], C, mnC);
#pragma unroll
  for (int r = 0; r < 16; ++r) p0[r] = __builtin_amdgcn_exp2f(p0[r]);
}
__device__ __forceinline__ void finishSM(f32x16& p0, f32x16& p1, float alpha, float& l_reg, bf16x8& pa0, bf16x8& pa1, bf16x8& pa2, bf16x8& pa3) {
#pragma unroll
  for (int r = 0; r < 16; ++r) p1[r] = __builtin_amdgcn_exp2f(p1[r]);
  float ps = 0;
#pragma unroll
  for (int r = 0; r < 16; ++r) ps += p0[r];
#pragma unroll
  for (int r = 0; r < 16; ++r) ps += p1[r];
  { auto rr = __builtin_amdgcn_permlane32_swap(__float_as_uint(ps), __float_as_uint(ps), false, false);
    ps = __uint_as_float(rr[0]) + __uint_as_float(rr[1]); }
  l_reg = l_reg * alpha + ps;
#define PK4(P, BASE, OUT) do { unsigned a0 = cvtpk(P[BASE + 0], P[BASE + 1]), a1 = cvtpk(P[BASE + 2], P[BASE + 3]);   \
    unsigned b0 = cvtpk(P[BASE + 4], P[BASE + 5]), b1 = cvtpk(P[BASE + 6], P[BASE + 7]);                              \
    auto r0 = __builtin_amdgcn_permlane32_swap(a0, b0, false, false); auto r1 = __builtin_amdgcn_permlane32_swap(a1, b1, false, false); \
    u32x4 w = {r0[0], r1[0], r0[1], r1[1]}; OUT = *reinterpret_cast<bf16x8*>(&w); } while (0)
  PK4(p0, 0, pa0); PK4(p0, 8, pa1); PK4(p1, 0, pa2); PK4(p1, 8, pa3);
#undef PK4
}
template <bool WIN>
__device__ __forceinline__ void qkt(f32x16& p0, f32x16& p1, const bf16_t* Ks, const bf16x8* qr, int r32, int hi, int dq) {
  p0 = f32x16{}; p1 = f32x16{};
  if (WIN) {
    const int t = 4 * hi - dq + 128;
#pragma unroll
    for (int r = 0; r < 16; ++r) { const unsigned d0 = (unsigned)(t + (r & 3) + 8 * (r >> 2)), d1 = d0 + 32u;
      p0[r] = d0 > 256u ? -1e30f : 0.f; p1[r] = d1 > 256u ? -1e30f : 0.f; }
  }
#pragma unroll
  for (int d0 = 0; d0 < 8; ++d0) { int cb = (d0 * 16 + hi * 8) * 2;
    bf16x8 b0 = *reinterpret_cast<const bf16x8*>((const char*)Ks + KSWZ(r32, cb));
    bf16x8 b1 = *reinterpret_cast<const bf16x8*>((const char*)Ks + KSWZ(32 + r32, cb));
    p0 = __builtin_amdgcn_mfma_f32_32x32x16_bf16(b0, qr[d0], p0, 0, 0, 0);
    p1 = __builtin_amdgcn_mfma_f32_32x32x16_bf16(b1, qr[d0], p1, 0, 0, 0); }
}
__device__ __forceinline__ int v_st(int k, int c) { const int kk = (k & ~0xC) | ((k & 4) << 1) | ((k & 8) >> 1); return ((kk >> 3) * 4 + (c >> 5)) * 512 + ((kk & 7) * 32 + (c & 31)) * 2; }
__device__ __forceinline__ int v_rd_base(int lane) { return ((lane & 3) << 3) | (((lane >> 2) & 3) << 6) | (((lane >> 4) & 1) << 5) | (((lane >> 5) & 1) << 8); }
constexpr int v_rd_off(int d0, int ks, int half) { return d0 * 512 + ks * 4096 + half * 2048; }
template <int OFF> __device__ __forceinline__ s16x4 tr_read(int vb) {
  s16x4 r; asm volatile("ds_read_b64_tr_b16 %0, %1 offset:%2" : "=&v"(r) : "v"(vb), "i"(OFF) : "memory"); return r;
}
template <int D0> __device__ __forceinline__ void pv_one(f32x16& od, int vb, bf16x8 pa0, bf16x8 pa1, bf16x8 pa2, bf16x8 pa3) {
  const s16x4 l0 = tr_read<v_rd_off(D0, 0, 0)>(vb), h0 = tr_read<v_rd_off(D0, 0, 1)>(vb), l1 = tr_read<v_rd_off(D0, 1, 0)>(vb), h1 = tr_read<v_rd_off(D0, 1, 1)>(vb);
  const s16x4 l2 = tr_read<v_rd_off(D0, 2, 0)>(vb), h2 = tr_read<v_rd_off(D0, 2, 1)>(vb), l3 = tr_read<v_rd_off(D0, 3, 0)>(vb), h3 = tr_read<v_rd_off(D0, 3, 1)>(vb);
  asm volatile("s_waitcnt lgkmcnt(0)" ::: "memory"); SBAR();
#define PK(L, H) (bf16x8){L[0], L[1], L[2], L[3], H[0], H[1], H[2], H[3]}
  od = __builtin_amdgcn_mfma_f32_32x32x16_bf16(pa0, PK(l0, h0), od, 0, 0, 0);
  od = __builtin_amdgcn_mfma_f32_32x32x16_bf16(pa1, PK(l1, h1), od, 0, 0, 0);
  od = __builtin_amdgcn_mfma_f32_32x32x16_bf16(pa2, PK(l2, h2), od, 0, 0, 0);
  od = __builtin_amdgcn_mfma_f32_32x32x16_bf16(pa3, PK(l3, h3), od, 0, 0, 0);
#undef PK
}
__device__ __forceinline__ void pv_d0(f32x16* o, int vb, bf16x8 pa0, bf16x8 pa1, bf16x8 pa2, bf16x8 pa3) {
  pv_one<0>(o[0], vb, pa0, pa1, pa2, pa3); pv_one<1>(o[1], vb, pa0, pa1, pa2, pa3); pv_one<2>(o[2], vb, pa0, pa1, pa2, pa3); pv_one<3>(o[3], vb, pa0, pa1, pa2, pa3);
}

template <bool WIN, int LDO>
__device__ __forceinline__ void attn_unit(const bf16_t* __restrict__ Qb, const bf16_t* __restrict__ Kh, const bf16_t* __restrict__ Vh,
                                          bf16_t* __restrict__ Ob, int NT, int dq_base, float m_init, float l_init, char* lds) {
  const int tid = threadIdx.x, wid = tid >> 6, lane = tid & 63, r32 = lane & 31, hi = lane >> 5;
  bf16_t* V_lds = (bf16_t*)lds; bf16_t* K_lds = (bf16_t*)(lds + 2 * SHM_V);
  float* ws = (float*)(lds + 2 * SHM_V + 2 * SHM_K) + wid * 64; float* li_l = ws; float* al_l = ws + 32;
  float m_reg = m_init, l_reg = l_init; f32x16 o[4] = {}; bf16x8 qr[8];
  const int dq0 = dq_base + wid * QBLK + r32;
  const bf16_t* Qw = Qb + (long)(wid * QBLK + r32) * LDQ + hi * 8;
#pragma unroll
  for (int d0 = 0; d0 < 8; ++d0) qr[d0] = ld8(Qw + d0 * 16);
  const int sr = tid >> 4, sc = (tid & 15) * 8, vst0 = v_st(sr, sc), vst1 = v_st(32 + sr, sc);
  const int vb0 = (int)(uintptr_t)V_lds + v_rd_base(lane);
  bf16x8 vsA0, vsA1, ksA0, ksA1, vsB0, vsB1, ksB0, ksB1;
  const unsigned goff = (unsigned)(sr * LDK + sc) * 2u;
#define GLD(base, k0, extra) (*reinterpret_cast<const bf16x8*>((const char*)(base) + (size_t)(k0) * (LDK * 2) + (extra) + goff))
#define SLOAD_A(k0) do { vsA0 = GLD(Vh, k0, 0); vsA1 = GLD(Vh, k0, 32 * LDK * 2); ksA0 = GLD(Kh, k0, 0); ksA1 = GLD(Kh, k0, 32 * LDK * 2); } while (0)
#define SLOAD_B(k0) do { vsB0 = GLD(Vh, k0, 0); vsB1 = GLD(Vh, k0, 32 * LDK * 2); ksB0 = GLD(Kh, k0, 0); ksB1 = GLD(Kh, k0, 32 * LDK * 2); } while (0)
#define SWRITE_A() do { *(bf16x8*)((char*)V_lds + vst0) = vsA0; *(bf16x8*)((char*)V_lds + vst1) = vsA1; const int kc = sc * 2; \
    *(bf16x8*)((char*)K_lds + KSWZ(sr, kc)) = ksA0; *(bf16x8*)((char*)K_lds + KSWZ(32 + sr, kc)) = ksA1; } while (0)
#define SWRITE_B() do { *(bf16x8*)((char*)V_lds + SHM_V + vst0) = vsB0; *(bf16x8*)((char*)V_lds + SHM_V + vst1) = vsB1; const int kc = sc * 2; \
    *(bf16x8*)((char*)K_lds + SHM_K + KSWZ(sr, kc)) = ksB0; *(bf16x8*)((char*)K_lds + SHM_K + KSWZ(32 + sr, kc)) = ksB1; } while (0)
#define SWAIT() asm volatile("s_waitcnt vmcnt(4)" ::: "memory")
#define RESC(a) do { if (__any((a) < 1.f)) { if (hi == 0) al_l[r32] = (a); asm volatile("s_waitcnt lgkmcnt(0)" ::: "memory"); \
    _Pragma("unroll") for (int d = 0; d < 4; ++d) _Pragma("unroll") for (int r = 0; r < 16; ++r) o[d][r] *= al_l[crow(r, hi)]; } } while (0)
  f32x16 pA0, pA1, pB0, pB1; float mnA, mnB, alA, alB; bf16x8 pa0, pa1, pa2, pa3;
  SLOAD_A(0); asm volatile("s_waitcnt vmcnt(0)" ::: "memory"); SWRITE_A(); __syncthreads();
  qkt<WIN>(pA0, pA1, K_lds, qr, r32, hi, dq0); partialSM<WIN>(pA0, pA1, m_reg, mnA, alA);
  SLOAD_B(KVBLK); if (2 < NT) SLOAD_A(2 * KVBLK);
  SWAIT(); SWRITE_B(); __syncthreads();
  for (int j = 1; j + 1 < NT; j += 2) {
    SBAR(); qkt<WIN>(pB0, pB1, (bf16_t*)((char*)K_lds + SHM_K), qr, r32, hi, dq0 - j * KVBLK);
    finishSM(pA0, pA1, alA, l_reg, pa0, pa1, pa2, pa3); SBAR();
    SLOAD_B((j + 2) * KVBLK); SBAR();
    pv_d0(o, vb0, pa0, pa1, pa2, pa3); partialSM<WIN>(pB0, pB1, m_reg, mnB, alB);
    __syncthreads(); SWAIT(); SWRITE_A();
    RESC(alB); __syncthreads();
    SBAR(); qkt<WIN>(pA0, pA1, K_lds, qr, r32, hi, dq0 - (j + 1) * KVBLK);
    finishSM(pB0, pB1, alB, l_reg, pa0, pa1, pa2, pa3); SBAR();
    if (j + 3 < NT) SLOAD_A((j + 3) * KVBLK); SBAR();
    pv_d0(o, vb0 + (int)SHM_V, pa0, pa1, pa2, pa3); partialSM<WIN>(pA0, pA1, m_reg, mnA, alA);
    __syncthreads(); SWAIT(); SWRITE_B();
    RESC(alA); __syncthreads();
  }
  SBAR(); qkt<WIN>(pB0, pB1, (bf16_t*)((char*)K_lds + SHM_K), qr, r32, hi, dq0 - (NT - 1) * KVBLK);
  finishSM(pA0, pA1, alA, l_reg, pa0, pa1, pa2, pa3); SBAR();
  pv_d0(o, vb0, pa0, pa1, pa2, pa3); partialSM<WIN>(pB0, pB1, m_reg, mnB, alB);
  __syncthreads(); RESC(alB);
  finishSM(pB0, pB1, alB, l_reg, pa0, pa1, pa2, pa3); SBAR();
  pv_d0(o, vb0 + (int)SHM_V, pa0, pa1, pa2, pa3);
  if (hi == 0) li_l[r32] = l_reg; asm volatile("s_waitcnt lgkmcnt(0)" ::: "memory");
  float rli[16];
#pragma unroll
  for (int r = 0; r < 16; ++r) rli[r] = __builtin_amdgcn_rcpf(li_l[crow(r, hi)]);
  bf16_t* Ow = Ob + (long)(wid * QBLK) * LDO;
#pragma unroll
  for (int r = 0; r < 16; ++r) { const int orow = crow(r, hi);
#pragma unroll
    for (int d0 = 0; d0 < 4; ++d0) Ow[(long)orow * LDO + d0 * 32 + r32] = (bf16_t)(cvtpk(o[d0][r] * rli[r], 0.f) & 0xffffu); }
  __syncthreads();
#undef SLOAD_A
#undef GLD
#undef SLOAD_B
#undef SWRITE_A
#undef SWRITE_B
#undef SWAIT
#undef RESC
}

#define LAS3 __attribute__((address_space(3)))
constexpr int DV_K0 = 0, DV_V0 = 32768, DV_WS = 98304, DV_LDS = DV_WS + NW * 256;
__device__ __forceinline__ void dma16(const void* g, LAS3 unsigned char* l) { __builtin_amdgcn_global_load_lds((const unsigned*)g, (LAS3 unsigned*)l, 16, 0, 0); }
template <int LDO>
__device__ __forceinline__ void attn_unit_dv(const bf16_t* __restrict__ Qb, const bf16_t* __restrict__ Kh, const bf16_t* __restrict__ Vh, bf16_t* __restrict__ Ob, int NT, char* lds, LAS3 unsigned char* ldsl) {
  const int tid = threadIdx.x, lane = tid & 63, r32 = lane & 31, hi = lane >> 5; const int wid = __builtin_amdgcn_readfirstlane(tid >> 6);
  float* ws = (float*)(lds + DV_WS) + wid * 64; float* li_l = ws; float* al_l = ws + 32;
  float m_reg = -1e30f, l_reg = 0.f; f32x16 o[8] = {}; bf16x8 qr[8];
  const unsigned koff0 = (unsigned)((8 * wid + (lane >> 4)) * (LDK * 2) + (((lane & 15) ^ (lane >> 4)) << 4));
  const int hf = wid >> 2;
  unsigned voff0;
  { const int lc = (4 * wid) & 15, b = lc * 1024 + 16 * lane, sub = b >> 9, e = (b & 511) >> 1;
    const int kk = (sub >> 2) * 8 + (e >> 5), c = (sub & 3) * 32 + (e & 31), k = (kk & ~0xC) | ((kk & 4) << 1) | ((kk & 8) >> 1);
    voff0 = (unsigned)(k * (LDV2 * 2) + (hf * 128 + c) * 2); }
  LAS3 unsigned char* kdst = ldsl + DV_K0 + wid * 2048;
  LAS3 unsigned char* vdst = ldsl + DV_V0 + hf * 16384 + ((4 * wid) & 15) * 1024;
#define DMA_KV(t, buf) do { const char* kb_ = (const char*)Kh + (size_t)(t) * (64 * LDK * 2); const char* vb_ = (const char*)Vh + (size_t)(t) * (64 * LDV2 * 2); \
    dma16(kb_ + koff0, kdst + (buf) * 16384); dma16(kb_ + 4 * (LDK * 2) + (koff0 ^ 64u), kdst + (buf) * 16384 + 1024); \
    dma16(vb_ + voff0, vdst + (buf) * 32768); dma16(vb_ + 128 + voff0, vdst + (buf) * 32768 + 1024); \
    dma16(vb_ + 4 * (LDV2 * 2) + voff0, vdst + (buf) * 32768 + 2048); dma16(vb_ + 4 * (LDV2 * 2) + 128 + voff0, vdst + (buf) * 32768 + 3072); } while (0)
#define RESC8(a) do { if (__any((a) < 1.f)) { if (hi == 0) al_l[r32] = (a); asm volatile("s_waitcnt lgkmcnt(0)" ::: "memory"); \
    _Pragma("unroll") for (int d = 0; d < 8; ++d) _Pragma("unroll") for (int r = 0; r < 16; ++r) o[d][r] *= al_l[crow(r, hi)]; } } while (0)
  if (wid >= 4) __builtin_amdgcn_s_setprio(1);
  DMA_KV(0, 0);
  const bf16_t* Qw = Qb + (long)(wid * QBLK + r32) * LDQ + hi * 8;
#pragma unroll
  for (int d0 = 0; d0 < 8; ++d0) qr[d0] = ld8(Qw + d0 * 16);
  const int vb0 = (int)(uintptr_t)(lds + DV_V0) + v_rd_base(lane);
  asm volatile("s_waitcnt vmcnt(0) lgkmcnt(0)" ::: "memory"); __builtin_amdgcn_s_barrier(); asm volatile("" ::: "memory");
  for (int t = 0; t < NT; ++t) {
    const int buf = t & 1;
    f32x16 p0, p1; float mn, alpha; bf16x8 pa0, pa1, pa2, pa3;
    qkt<false>(p0, p1, (const bf16_t*)(lds + DV_K0 + buf * 16384), qr, r32, hi, 0);
    SBAR();
    if (t + 1 < NT) DMA_KV(t + 1, buf ^ 1);
    SBAR();
    partialSM<false>(p0, p1, m_reg, mn, alpha);
    finishSM(p0, p1, alpha, l_reg, pa0, pa1, pa2, pa3);
    RESC8(alpha);
    SBAR();
    pv_d0(o, vb0 + buf * 32768, pa0, pa1, pa2, pa3);
    pv_d0(o + 4, vb0 + buf * 32768 + 16384, pa0, pa1, pa2, pa3);
    asm volatile("s_waitcnt vmcnt(0) lgkmcnt(0)" ::: "memory"); __builtin_amdgcn_s_barrier(); asm volatile("" ::: "memory");
  }
  __builtin_amdgcn_s_setprio(0);
  if (hi == 0) li_l[r32] = l_reg; asm volatile("s_waitcnt lgkmcnt(0)" ::: "memory");
  float rli[16];
#pragma unroll
  for (int r = 0; r < 16; ++r) rli[r] = __builtin_amdgcn_rcpf(li_l[crow(r, hi)]);
  bf16_t* Ow = Ob + (long)(wid * QBLK) * LDO;
#pragma unroll
  for (int r = 0; r < 16; ++r) { const int orow = crow(r, hi);
#pragma unroll
    for (int d0 = 0; d0 < 8; ++d0) Ow[(long)orow * LDO + d0 * 32 + r32] = (bf16_t)(cvtpk(o[d0][r] * rli[r], 0.f) & 0xffffu); }
#undef DMA_KV
#undef RESC8
}
#undef KSWZ
#undef SBAR
}

#define GAS __attribute__((address_space(1)))
#define LAS __attribute__((address_space(3)))
typedef unsigned short bf16;
typedef unsigned v4u __attribute__((ext_vector_type(4)));
typedef float f32x4 __attribute__((ext_vector_type(4)));

constexpr int NWAVES = 8;
constexpr int M = 32768, DM = 2048, FF = 5632, SEQ = 16384, WIN_COLS = 8704;
constexpr float EPS = 1e-6f;
constexpr size_t MiB = 1u << 20;
constexpr size_t WS_W1GU = 0, WS_W1D = 44 * MiB, WS_W2GU = 66 * MiB, WS_W2D = 110 * MiB, WS_WIN = 132 * MiB, WS_WPA = 166 * MiB, WS_WPB = 170 * MiB, WS_WOUT = 174 * MiB;
constexpr size_t WS_COS = 182 * MiB, WS_SIN = 186 * MiB;
constexpr size_t WS_B = 190 * MiB;
constexpr size_t WS_C = 318 * MiB;
constexpr size_t WS_D = 446 * MiB;
constexpr size_t WS_CTL = 990 * MiB, CTL_BYTES = 65536;
constexpr size_t WS_END = 991 * MiB;
constexpr int LDS_BYTES = 134 * 1024;
constexpr int NPHASE = 14;
#ifndef MK_PER_PHASE
#define MK_PER_PHASE 0
#endif
#ifndef PH_LIMIT
#define PH_LIMIT NPHASE
#endif

__device__ __forceinline__ unsigned f2bf(float f) { unsigned u = __builtin_bit_cast(unsigned, f); return (u + 0x7fffu + ((u >> 16) & 1u)) >> 16; }
__device__ __forceinline__ unsigned pk2(float lo, float hi) { return pg8::cvt_pk_bf16(lo, hi); }
__device__ __forceinline__ float wave_sum(float v) {
#pragma unroll
    for (int o = 1; o < 64; o <<= 1) v += __shfl_xor(v, o);
    return v;
}
__device__ __forceinline__ void transpose_item(const float* W, int K, int N, bf16* WT, int dst_row0, int k0, int n0, LAS float* scr, int lane) {
    { const int rr = lane >> 3, c4 = (lane & 7) * 4;
      f32x4 t[8];
#pragma unroll
      for (int i = 0; i < 8; ++i) t[i] = *(const f32x4*)(W + (size_t)(k0 + 8 * i + rr) * N + n0 + c4);
#pragma unroll
      for (int i = 0; i < 8; ++i) { LAS float* d = scr + (8 * i + rr) * 33 + c4; d[0] = t[i][0]; d[1] = t[i][1]; d[2] = t[i][2]; d[3] = t[i][3]; } }
    asm volatile("s_waitcnt lgkmcnt(0)" ::: "memory");
    const int c = lane & 7;
#pragma unroll
    for (int j = 0; j < 4; ++j) { const int n = (lane >> 3) + 8 * j; const LAS float* s = scr + (8 * c) * 33 + n;
        v4u o; o.x = pk2(s[0 * 33], s[1 * 33]); o.y = pk2(s[2 * 33], s[3 * 33]); o.z = pk2(s[4 * 33], s[5 * 33]); o.w = pk2(s[6 * 33], s[7 * 33]);
        *(v4u*)(WT + (size_t)(dst_row0 + n) * K + k0 + 8 * c) = o; }
    asm volatile("s_waitcnt lgkmcnt(0)" ::: "memory");
}
__device__ __forceinline__ int win_row(int n0) {
    const int pn = n0 >> 8; const bool rope = (pn <= 4) || (pn >= 6 && pn <= 13);
    if (!rope) return n0;
    const int rem = n0 & 255; return (pn << 8) + (((rem & 127) >> 6) << 7) + ((rem >> 7) << 6) + (rem & 63);
}
__device__ __forceinline__ void ld_row_f32(const float* p, int lane, f32x4 (&v)[8]) {
#pragma unroll
    for (int j = 0; j < 4; ++j) { const f32x4* q = (const f32x4*)(p + 8 * (lane + 64 * j)); v[2 * j] = q[0]; v[2 * j + 1] = q[1]; }
}
__device__ __forceinline__ void st_row_f32(float* p, int lane, const f32x4 (&v)[8]) {
#pragma unroll
    for (int j = 0; j < 4; ++j) { f32x4* q = (f32x4*)(p + 8 * (lane + 64 * j)); q[0] = v[2 * j]; q[1] = v[2 * j + 1]; }
}
__device__ __forceinline__ void ld_row_bf16(const bf16* p, int lane, f32x4 (&v)[8]) {
#pragma unroll
    for (int j = 0; j < 4; ++j) { const v4u w = *(const v4u*)(p + 8 * (lane + 64 * j));
        v[2 * j] = (f32x4){pg8::bf_lo(w.x), pg8::bf_hi(w.x), pg8::bf_lo(w.y), pg8::bf_hi(w.y)}; v[2 * j + 1] = (f32x4){pg8::bf_lo(w.z), pg8::bf_hi(w.z), pg8::bf_lo(w.w), pg8::bf_hi(w.w)}; }
}
__device__ __forceinline__ void st_row_bf16(bf16* p, int lane, const f32x4 (&v)[8]) {
#pragma unroll
    for (int j = 0; j < 4; ++j) { v4u w; w.x = pk2(v[2 * j][0], v[2 * j][1]); w.y = pk2(v[2 * j][2], v[2 * j][3]); w.z = pk2(v[2 * j + 1][0], v[2 * j + 1][1]); w.w = pk2(v[2 * j + 1][2], v[2 * j + 1][3]);
        *(v4u*)(p + 8 * (lane + 64 * j)) = w; }
}
__device__ __forceinline__ float row_rstd(const f32x4 (&v)[8]) {
    float s = 0.f;
#pragma unroll
    for (int j = 0; j < 8; ++j) s += (v[j][0] * v[j][0] + v[j][1] * v[j][1]) + (v[j][2] * v[j][2] + v[j][3] * v[j][3]);
    return __builtin_amdgcn_rsqf(wave_sum(s) * (1.0f / DM) + EPS);
}
__device__ __forceinline__ void ld_row_raw(const bf16* p, int lane, v4u (&w)[4]) {
#pragma unroll
    for (int j = 0; j < 4; ++j) w[j] = *(const v4u*)(p + 8 * (lane + 64 * j));
}
__device__ __forceinline__ void unpack_row(const v4u (&w)[4], f32x4 (&v)[8]) {
#pragma unroll
    for (int j = 0; j < 4; ++j) { v[2 * j] = (f32x4){pg8::bf_lo(w[j].x), pg8::bf_hi(w[j].x), pg8::bf_lo(w[j].y), pg8::bf_hi(w[j].y)}; v[2 * j + 1] = (f32x4){pg8::bf_lo(w[j].z), pg8::bf_hi(w[j].z), pg8::bf_lo(w[j].w), pg8::bf_hi(w[j].w)}; }
}
template <bool BB, bool OB>
__device__ __forceinline__ void residual_rows(const bf16* F, const void* basev, void* outv, const float* g_post, float alpha, const float* g_next, bf16* XN, int gw, int NGW, int lane) {
    const char* base = (const char*)basev; char* out = (char*)outv;
    v4u fw[4], bw[4]; f32x4 b[8];
    f32x4 gp[8], gn[8];
    ld_row_f32(g_post, lane, gp); if (XN) ld_row_f32(g_next, lane, gn);
    int m = gw;
    if (m < M) { ld_row_raw(F + (size_t)m * DM, lane, fw);
        if (BB) ld_row_raw((const bf16*)(base + (size_t)m * 8192), lane, bw); else ld_row_f32((const float*)(base + (size_t)m * 8192), lane, b); }
    for (; m < M; m += NGW) {
        const int mn = m + NGW; const bool more = mn < M;
        v4u fwn[4], bwn[4]; f32x4 bn[8];
        if (more) { ld_row_raw(F + (size_t)mn * DM, lane, fwn);
            if (BB) ld_row_raw((const bf16*)(base + (size_t)mn * 8192), lane, bwn); else ld_row_f32((const float*)(base + (size_t)mn * 8192), lane, bn); }
        f32x4 f[8];
        unpack_row(fw, f); if (BB) unpack_row(bw, b);
        const float r1 = row_rstd(f) * alpha;
#pragma unroll
        for (int j = 0; j < 8; ++j) b[j] = b[j] + f[j] * r1 * gp[j];
        if (OB) st_row_bf16((bf16*)(out + (size_t)m * 8192), lane, b); else st_row_f32((float*)(out + (size_t)m * 8192), lane, b);
        if (XN) { const float r2 = row_rstd(b);
#pragma unroll
            for (int j = 0; j < 8; ++j) b[j] = b[j] * r2 * gn[j];
            st_row_bf16(XN + (size_t)m * DM, lane, b); }
        if (more) {
#pragma unroll
            for (int j = 0; j < 4; ++j) { fw[j] = fwn[j]; if (BB) bw[j] = bwn[j]; }
            if (!BB) {
#pragma unroll
                for (int j = 0; j < 8; ++j) b[j] = bn[j]; } }
    }
}

#define XB_TMO      128
#define XB_XCNT(j)  (256  + 64 * (j))
#define XB_XSUB(j)  (1280 + 64 * (j))
#define XB_XGEN(j)  (2304 + 64 * (j))
#define XB_TOP      3328
#define XB_TOPGEN   3392
#define XCD_BAR_WORDS 3456
#define XB_SPIN_CAP (1u << 18)

__device__ __forceinline__ unsigned xb_ld(unsigned* p)              { return __hip_atomic_load(p, __ATOMIC_RELAXED, __HIP_MEMORY_SCOPE_AGENT); }
__device__ __forceinline__ unsigned xb_add(unsigned* p, unsigned v) { return __hip_atomic_fetch_add(p, v, __ATOMIC_RELAXED, __HIP_MEMORY_SCOPE_AGENT); }
__device__ __forceinline__ unsigned xb_xcc_id() { return (unsigned)__builtin_amdgcn_s_getreg((3 << 11) | 20) & 0xFu; }
#define XB_SPIN(cond, bar) do { unsigned _sp = 0; while (cond) { __builtin_amdgcn_s_sleep(1); \
    if ((++_sp & 255u) == 0u) { if (xb_ld(&(bar)[XB_TMO])) break; if (_sp > XB_SPIN_CAP) { atomicAdd(&(bar)[XB_TMO], 1u); break; } } } } while (0)

struct XcdBarrier {
    unsigned* bar; unsigned x;
    volatile LAS unsigned* st;
};

__device__ __forceinline__ XcdBarrier xcd_barrier_post(unsigned* bar, volatile LAS unsigned* st) {
    XcdBarrier b; b.bar = bar; b.x = xb_xcc_id(); b.st = st;
    if (threadIdx.x == 0) (void)xb_add(&bar[XB_XCNT(b.x)], 1u);
    return b;
}
__device__ __forceinline__ void xcd_barrier_complete(unsigned* bar, unsigned x, unsigned& nloc, unsigned& nx) {
    const unsigned G = gridDim.x * gridDim.y * gridDim.z;
    unsigned sum, cnt, mine, sp = 0u;
    for (;;) {
        sum = 0u; cnt = 0u; mine = 0u;
#pragma unroll
        for (unsigned j = 0; j < 16; ++j) { const unsigned c = xb_ld(&bar[XB_XCNT(j)]); sum += c; cnt += (c > 0u) ? 1u : 0u; mine = (j == x) ? c : mine; }
        if (sum == G) break;
        __builtin_amdgcn_s_sleep(1);
        if ((++sp & 255u) == 0u) { if (xb_ld(&bar[XB_TMO])) break; if (sp > XB_SPIN_CAP) { atomicAdd(&bar[XB_TMO], 1u); break; } }
    }
    nloc = mine > 0u ? mine : 1u; nx = cnt > 0u ? cnt : 1u;
}

__device__ __forceinline__ void xcd_barrier(const XcdBarrier& b) {
    asm volatile("s_waitcnt vmcnt(0)" ::: "memory");
    __syncthreads();
    if (threadIdx.x == 0) {
        unsigned* bar = b.bar;
        __builtin_amdgcn_s_waitcnt(0);
        unsigned nloc = b.st[0], nx = b.st[1];
        if (nloc == 0u) { xcd_barrier_complete(bar, b.x, nloc, nx); b.st[0] = nloc; b.st[1] = nx; }
        const unsigned old = xb_add(&bar[XB_XSUB(b.x)], 1u);
        const unsigned gen = old / nloc;
        if (old + 1u == (gen + 1u) * nloc) {
            __builtin_amdgcn_fence(__ATOMIC_RELEASE, "agent");
            asm volatile("s_waitcnt vmcnt(0)" ::: "memory");
            const unsigned og = xb_add(&bar[XB_TOP], 1u);
            const unsigned tg = og / nx;
            if (og + 1u == (tg + 1u) * nx) xb_add(&bar[XB_TOPGEN], 1u);
            else XB_SPIN(xb_ld(&bar[XB_TOPGEN]) == tg, bar);
            __builtin_amdgcn_fence(__ATOMIC_ACQUIRE, "agent");
            xb_add(&bar[XB_XGEN(b.x)], 1u);
            asm volatile("s_waitcnt vmcnt(0)" ::: "memory");
        } else {
            XB_SPIN(xb_ld(&bar[XB_XGEN(b.x)]) == gen, bar);
            __builtin_amdgcn_fence(__ATOMIC_ACQUIRE, "agent");
            asm volatile("s_waitcnt vmcnt(0)" ::: "memory");
        }
    }
    __syncthreads();
}

struct Args { const float* in[24]; float* out; unsigned char* ws; int ph_lo, ph_hi; };

__global__ void __launch_bounds__(NWAVES * 64, 2) mk_fwd(Args args) {
    extern __shared__ __attribute__((aligned(16))) unsigned char lds[];
    cg::grid_group grid = cg::this_grid();
    const int tid = threadIdx.x, lane = tid & 63, wave = __builtin_amdgcn_readfirstlane(tid >> 6);
    const int G = gridDim.x, bx = blockIdx.x, vcu = (G % 8 == 0) ? (bx % 8) * (G / 8) + bx / 8 : bx;
    const int gw = vcu * NWAVES + wave, NGW = G * NWAVES;
    unsigned char* ws = args.ws;
    const float* x = args.in[0]; float* out = args.out;
    bf16* W1GU = (bf16*)(ws + WS_W1GU); bf16* W1D = (bf16*)(ws + WS_W1D); bf16* W2GU = (bf16*)(ws + WS_W2GU); bf16* W2D = (bf16*)(ws + WS_W2D);
    bf16* WIN = (bf16*)(ws + WS_WIN); bf16* WPA = (bf16*)(ws + WS_WPA); bf16* WPB = (bf16*)(ws + WS_WPB); bf16* WOUT = (bf16*)(ws + WS_WOUT);
    float* cosT = (float*)(ws + WS_COS); float* sinT = (float*)(ws + WS_SIN);
    bf16* RB = (bf16*)(ws + WS_B); bf16* RC = (bf16*)(ws + WS_C); bf16* RD = (bf16*)(ws + WS_D);
    bf16* OA = RB; bf16* OB = RB + (size_t)M * 1024;
    bf16* GA = RD; bf16* GB = RD + (size_t)64 * MiB; bf16* QB = RD + (size_t)128 * MiB; bf16* KB = RD + (size_t)160 * MiB; bf16* VB = RD + (size_t)192 * MiB;
    bf16* QA = RD + (size_t)224 * MiB; bf16* KA = RD + (size_t)256 * MiB; bf16* VA = RD + (size_t)264 * MiB;
    LAS unsigned char* ldsl = (LAS unsigned char*)lds;
    const int lo = args.ph_lo, hi = args.ph_hi;
    volatile LAS unsigned* bst = (volatile LAS unsigned*)(ldsl + 133120 + 64);
    if (tid < 2) bst[tid] = 0u;
    __syncthreads();
    if (blockIdx.x == 0) { unsigned* cw = (unsigned*)(ws + WS_CTL); for (int i = tid; i < XCD_BAR_WORDS; i += NWAVES * 64) cw[i] = 0u; }
    asm volatile("s_waitcnt vmcnt(0)" ::: "memory"); __syncthreads();
    grid.sync();
    XcdBarrier bar = xcd_barrier_post((unsigned*)(ws + WS_CTL), bst);
#ifndef PH_MASK
#define PH_MASK 0x3fff
#endif
#define IN(k) (((PH_MASK >> (k)) & 1) && lo <= (k) && (k) < hi)
#ifndef ATT_REP
#define ATT_REP 1
#endif
#ifndef PROBE_TWICE
#define PROBE_TWICE 0
#endif
#define REP(k) for (int rep_ = 0; rep_ < 1 + ((PROBE_TWICE >> (k)) & 1); ++rep_)
#define SEAM(k) do { if (IN(k) && IN((k) + 1)) xcd_barrier(bar); } while (0)

    if (IN(0)) REP(0) {
        LAS float* scr = (LAS float*)(ldsl + wave * 16384);
        constexpr int C_GU = (DM / 64) * (FF / 32), C_D = (FF / 64) * (DM / 32), C_IN = (DM / 64) * (WIN_COLS / 32), C_P = (1024 / 64) * (DM / 32), C_O = (DM / 64) * (DM / 32);
        constexpr int NITEMS = 4 * C_GU + 2 * C_D + C_IN + 2 * C_P + C_O;
        struct TrItem { const float* src; bf16* dst; int N, K; };
        const int rr = lane >> 3, c4 = (lane & 7) * 4;
#define TR_DEC(IT, I) do { int r = (IT); bool done_ = false; \
            TR_MAT(args.in[2], DM, FF, W1GU, C_GU, 256 * (n0 >> 7) + (n0 & 127), I) TR_MAT(args.in[3], DM, FF, W1GU, C_GU, 256 * (n0 >> 7) + 128 + (n0 & 127), I) TR_MAT(args.in[4], FF, DM, W1D, C_D, n0, I) \
            TR_MAT(args.in[20], DM, FF, W2GU, C_GU, 256 * (n0 >> 7) + (n0 & 127), I) TR_MAT(args.in[21], DM, FF, W2GU, C_GU, 256 * (n0 >> 7) + 128 + (n0 & 127), I) TR_MAT(args.in[22], FF, DM, W2D, C_D, n0, I) \
            TR_MAT(args.in[7], DM, WIN_COLS, WIN, C_IN, win_row(n0), I) TR_MAT(args.in[15], 1024, DM, WPA, C_P, n0, I) TR_MAT(args.in[16], 1024, DM, WPB, C_P, n0, I) TR_MAT(args.in[17], DM, DM, WOUT, C_O, n0, I) } while (0)
#define TR_MAT(SRC, KK, NN, DST, CNT, ROWEXPR, I) if (!done_) { if (r < (CNT)) { const int nblk = (NN) / 32, kb = r / nblk, n0 = (r % nblk) * 32; \
            I.src = (SRC) + (size_t)(kb * 64 + rr) * (NN) + n0 + c4; I.dst = (DST) + (size_t)((ROWEXPR) + rr) * (KK) + kb * 64 + 8 * (lane & 7); I.N = (NN); I.K = (KK); done_ = true; } else r -= (CNT); }
#define TR_LOAD(I, T) do { _Pragma("unroll") for (int i = 0; i < 8; ++i) T[i] = *(const f32x4*)(I.src + (size_t)(8 * i) * I.N); } while (0)
#define TR_FIN(I, T) do { _Pragma("unroll") for (int i = 0; i < 8; ++i) { LAS float* d = scr + (8 * i + rr) * 33 + c4; d[0] = T[i][0]; d[1] = T[i][1]; d[2] = T[i][2]; d[3] = T[i][3]; } \
            asm volatile("s_waitcnt lgkmcnt(0)" ::: "memory"); \
            _Pragma("unroll") for (int j = 0; j < 4; ++j) { const LAS float* s_ = scr + (8 * (lane & 7)) * 33 + rr + 8 * j; \
                v4u o; o.x = pk2(s_[0 * 33], s_[1 * 33]); o.y = pk2(s_[2 * 33], s_[3 * 33]); o.z = pk2(s_[4 * 33], s_[5 * 33]); o.w = pk2(s_[6 * 33], s_[7 * 33]); \
                *(v4u*)(I.dst + (size_t)(8 * j) * I.K) = o; } \
            asm volatile("s_waitcnt lgkmcnt(0)" ::: "memory"); } while (0)
        { TrItem IA, IB; f32x4 tA[8], tB[8];
          int it = gw;
          if (it < NITEMS) { TR_DEC(it, IA); TR_LOAD(IA, tA); }
          for (; it < NITEMS; it += 2 * NGW) {
              const int i1 = it + NGW, i2 = it + 2 * NGW;
              TR_DEC(i1 < NITEMS ? i1 : it, IB); TR_LOAD(IB, tB);
              __builtin_amdgcn_sched_barrier(0);
              TR_FIN(IA, tA);
              __builtin_amdgcn_sched_barrier(0);
              TR_DEC(i2 < NITEMS ? i2 : it, IA); TR_LOAD(IA, tA);
              __builtin_amdgcn_sched_barrier(0);
              if (i1 < NITEMS) TR_FIN(IB, tB);
              __builtin_amdgcn_sched_barrier(0);
          } }
#undef TR_DEC
#undef TR_MAT
#undef TR_LOAD
#undef TR_FIN
        for (int idx = (vcu * NWAVES * 64 + tid); idx < SEQ * 64; idx += G * NWAVES * 64) {
            const int pos = idx >> 6, i = idx & 63;
            const double inv = exp(-(double)(2 * i) / 128.0 * 9.210340371976184);
            double s, c; sincos((double)pos * inv, &s, &c);
            cosT[idx] = (float)c; sinT[idx] = (float)s;
        }
        f32x4 g[8]; ld_row_f32(args.in[1], lane, g);
        for (int m = gw; m < M; m += NGW) {
            f32x4 v[8]; ld_row_f32(x + (size_t)m * DM, lane, v);
            const float r = row_rstd(v);
#pragma unroll
            for (int j = 0; j < 8; ++j) v[j] = v[j] * r * g[j];
            st_row_bf16(RB + (size_t)m * DM, lane, v);
        }
    }
    SEAM(0);
    if (IN(1)) REP(1) { pg8::Gemm g{RB, W1GU, M, 2 * FF, DM}; pg8::StaticOrder S; S.init(M, 2 * FF, G, bx); pg8::EpiSwiGLU E{RD, FF};
        pg8::gemm_phase<pg8::EpiSwiGLU, pg8::StaticOrder, true, true>(ldsl, g, S, E); }
    SEAM(1);
    if (IN(2)) REP(2) { pg8::Gemm g{RD, W1D, M, DM, FF}; pg8::StaticOrder S; S.init(M, DM, G, bx); pg8::EpiStore E{RC, DM};
        pg8::gemm_phase<pg8::EpiStore, pg8::StaticOrder, true, true>(ldsl, g, S, E); }
    SEAM(2);
    if (IN(3)) REP(3) residual_rows<false, true>(RC, x, out, args.in[5], 0.5f, args.in[6], RB, gw, NGW, lane);
    SEAM(3);
    if (IN(4)) REP(4) { pg8::Gemm g{RB, WIN, M, WIN_COLS, DM}; pg8::StaticOrder S; S.init(M, WIN_COLS, G, bx); pg8::EpiProj E{QA, KA, VA, QB, KB, VB, GA, GB, cosT, sinT, args.in[8]};
        pg8::gemm_phase<pg8::EpiProj, pg8::StaticOrder, true, true>(ldsl, g, S, E); }
    SEAM(4);
    if (IN(5)) REP(5) {

#ifndef NO_DENSE
        for (int id2 = vcu; id2 < 1024 * ATT_REP; id2 += G) { const int id = id2 & 1023;
            const int combo = id >> 6, qb = id & 63, b = combo >> 3, h = (combo >> 1) & 3, c = combo & 1;
            const bf16* Q = QB + ((size_t)(b * 8 + h * 2 + c) * SEQ + qb * 256) * 128;
            const bf16* K = KB + ((size_t)(b * 8 + h * 2 + c) * SEQ) * 128;
            const bf16* V = VB + ((size_t)(b * 4 + h) * SEQ) * 256;
            bf16* O = RC + (size_t)(b * SEQ + qb * 256) * 2048 + h * 512 + c * 256;
            att::attn_unit_dv<2048>(Q, K, V, O, SEQ / 64, (char*)lds, ldsl);
        }
#endif
#ifndef NO_WIN
        for (int id = vcu; id < 1024; id += G) {
            const int qb = id & 63, hq = (id >> 6) & 7, b = id >> 9, g = hq >> 2, q0 = qb * 256;
            const int klo = q0 >= 128 ? q0 - 128 : 0, khi = (q0 + 384 <= SEQ) ? q0 + 384 : SEQ;
            const bf16* Q = QA + ((size_t)(b * 8 + hq) * SEQ + q0) * 128;
            const bf16* K = KA + ((size_t)(b * 2 + g) * SEQ + klo) * 128;
            const bf16* V = VA + ((size_t)(b * 2 + g) * SEQ + klo) * 128;
            bf16* O = OA + (size_t)(b * SEQ + q0) * 1024 + hq * 128;
            att::attn_unit<true, 1024>(Q, K, V, O, (khi - klo) / 64, q0 - klo, args.in[9][hq] * (1.0f / att::SCALE), 1.f, (char*)lds);
        }
#endif
    }
    SEAM(5);
    if (IN(6)) REP(6) {
        const float a1 = wave_sum(args.in[10][lane] * args.in[11][lane] + args.in[10][lane + 64] * args.in[11][lane + 64]);
        const float a2 = wave_sum(args.in[12][lane] * args.in[13][lane] + args.in[12][lane + 64] * args.in[13][lane + 64]);
        const float lam = expf(a1) - expf(a2) + 0.2f;
        const int h = lane >> 4, e0 = (lane & 15) * 16;
        f32x4 sg[4];
#pragma unroll
        for (int j = 0; j < 4; ++j) sg[j] = *(const f32x4*)(args.in[14] + e0 + 4 * j) * 0.8f;
        for (int m = gw; m < M; m += NGW) {
            const bf16* p = RC + (size_t)m * 2048 + h * 512 + e0;
            const v4u w0 = *(const v4u*)p, w1 = *(const v4u*)(p + 8), u0 = *(const v4u*)(p + 256), u1 = *(const v4u*)(p + 264);
            f32x4 d[4];
            d[0] = (f32x4){pg8::bf_lo(w0.x), pg8::bf_hi(w0.x), pg8::bf_lo(w0.y), pg8::bf_hi(w0.y)} - lam * (f32x4){pg8::bf_lo(u0.x), pg8::bf_hi(u0.x), pg8::bf_lo(u0.y), pg8::bf_hi(u0.y)};
            d[1] = (f32x4){pg8::bf_lo(w0.z), pg8::bf_hi(w0.z), pg8::bf_lo(w0.w), pg8::bf_hi(w0.w)} - lam * (f32x4){pg8::bf_lo(u0.z), pg8::bf_hi(u0.z), pg8::bf_lo(u0.w), pg8::bf_hi(u0.w)};
            d[2] = (f32x4){pg8::bf_lo(w1.x), pg8::bf_hi(w1.x), pg8::bf_lo(w1.y), pg8::bf_hi(w1.y)} - lam * (f32x4){pg8::bf_lo(u1.x), pg8::bf_hi(u1.x), pg8::bf_lo(u1.y), pg8::bf_hi(u1.y)};
            d[3] = (f32x4){pg8::bf_lo(w1.z), pg8::bf_hi(w1.z), pg8::bf_lo(w1.w), pg8::bf_hi(w1.w)} - lam * (f32x4){pg8::bf_lo(u1.z), pg8::bf_hi(u1.z), pg8::bf_lo(u1.w), pg8::bf_hi(u1.w)};
            float s = 0.f;
#pragma unroll
            for (int j = 0; j < 4; ++j) s += (d[j][0] * d[j][0] + d[j][1] * d[j][1]) + (d[j][2] * d[j][2] + d[j][3] * d[j][3]);
            s += __shfl_xor(s, 1); s += __shfl_xor(s, 2); s += __shfl_xor(s, 4); s += __shfl_xor(s, 8);
            const float r = 1.0f / sqrtf(s * (1.0f / 256.0f) + EPS);
#pragma unroll
            for (int j = 0; j < 4; ++j) d[j] = d[j] * r * sg[j];
            v4u o0, o1; o0.x = pk2(d[0][0], d[0][1]); o0.y = pk2(d[0][2], d[0][3]); o0.z = pk2(d[1][0], d[1][1]); o0.w = pk2(d[1][2], d[1][3]);
            o1.x = pk2(d[2][0], d[2][1]); o1.y = pk2(d[2][2], d[2][3]); o1.z = pk2(d[3][0], d[3][1]); o1.w = pk2(d[3][2], d[3][3]);
            bf16* q = OB + (size_t)m * 1024 + h * 256 + e0; *(v4u*)q = o0; *(v4u*)(q + 8) = o1;
        }
    }
    SEAM(6);
    if (IN(7)) REP(7) { pg8::Gemm g{OA, WPA, M, DM, 1024}; pg8::StaticOrder S; S.init(M, DM, G, bx); pg8::EpiGate<0> E{RC, GA};
        pg8::gemm_phase<pg8::EpiGate<0>, pg8::StaticOrder, true, true>(ldsl, g, S, E); }
    SEAM(7);
    if (IN(8)) REP(8) { pg8::Gemm g{OB, WPB, M, DM, 1024}; pg8::StaticOrder S; S.init(M, DM, G, bx); pg8::EpiGate<1> E{RC, GB};
        pg8::gemm_phase<pg8::EpiGate<1>, pg8::StaticOrder, true, true>(ldsl, g, S, E); }
    SEAM(8);
    if (IN(9)) REP(9) { pg8::Gemm g{RC, WOUT, M, DM, DM}; pg8::StaticOrder S; S.init(M, DM, G, bx); pg8::EpiStore E{RB, DM};
        pg8::gemm_phase<pg8::EpiStore, pg8::StaticOrder, true, true>(ldsl, g, S, E); }
    SEAM(9);
    if (IN(10)) REP(10) residual_rows<true, true>(RB, out, out, args.in[18], 1.0f, args.in[19], RC, gw, NGW, lane);
    SEAM(10);
    if (IN(11)) REP(11) { pg8::Gemm g{RC, W2GU, M, 2 * FF, DM}; pg8::StaticOrder S; S.init(M, 2 * FF, G, bx); pg8::EpiSwiGLU E{RD, FF};
        pg8::gemm_phase<pg8::EpiSwiGLU, pg8::StaticOrder, true, true>(ldsl, g, S, E); }
    SEAM(11);
    if (IN(12)) REP(12) { pg8::Gemm g{RD, W2D, M, DM, FF}; pg8::StaticOrder S; S.init(M, DM, G, bx); pg8::EpiStore E{RB, DM};
        pg8::gemm_phase<pg8::EpiStore, pg8::StaticOrder, true, true>(ldsl, g, S, E); }
    SEAM(12);
    if (IN(13)) REP(13) residual_rows<true, false>(RB, out, out, args.in[23], 0.5f, nullptr, nullptr, gw, NGW, lane);
#undef IN
#undef SEAM
}

extern "C" void kernel_launch(void* const* d_in, const int* in_sizes, int n_in, void* d_out, int out_size, void* d_ws, size_t ws_size, hipStream_t stream) {
    static int grid = 0;
    if (grid == 0) {
        if (n_in != 24 || in_sizes[0] != M * DM || out_size != M * DM || ws_size < WS_END) { fprintf(stderr, "kernel_launch: shape/workspace mismatch (n_in %d, in0 %d, out %d, ws %zu < %zu)\n", n_in, n_in > 0 ? in_sizes[0] : -1, out_size, ws_size, (size_t)WS_END); grid = -1; return; }
        int dev = 0, cus = 0, per_cu = 0;
        if (hipGetDevice(&dev) != hipSuccess || hipDeviceGetAttribute(&cus, hipDeviceAttributeMultiprocessorCount, dev) != hipSuccess) { grid = -1; return; }
        if (hipFuncSetAttribute((const void*)mk_fwd, hipFuncAttributeMaxDynamicSharedMemorySize, LDS_BYTES) != hipSuccess) { fprintf(stderr, "kernel_launch: hipFuncSetAttribute failed\n"); grid = -1; return; }
        if (hipOccupancyMaxActiveBlocksPerMultiprocessor(&per_cu, (const void*)mk_fwd, NWAVES * 64, LDS_BYTES) != hipSuccess || per_cu < 1) { fprintf(stderr, "kernel_launch: occupancy query says %d\n", per_cu); per_cu = 1; }
        (void)hipGetLastError();
        grid = cus * per_cu;
    }
    if (grid < 0) return;
    Args a{};
    for (int i = 0; i < 24; ++i) a.in[i] = (const float*)d_in[i];
    a.out = (float*)d_out; a.ws = (unsigned char*)d_ws;
#if MK_PER_PHASE
    for (int p = 0; p < PH_LIMIT; ++p) { a.ph_lo = p; a.ph_hi = p + 1; hipLaunchKernelGGL(mk_fwd, dim3(grid), dim3(NWAVES * 64), LDS_BYTES, stream, a); }
#else
    a.ph_lo = 0; a.ph_hi = NPHASE;
    void* kargs[] = {&a};
    const hipError_t e = hipLaunchCooperativeKernel((const void*)mk_fwd, dim3(grid), dim3(NWAVES * 64), kargs, LDS_BYTES, stream);
    if (e != hipSuccess) fprintf(stderr, "kernel_launch: cooperative launch failed: %s (grid %d)\n", hipGetErrorString(e), grid);
#endif
}
```
